# Optimizing an MI355X kernel written in HIP

```python
import math
import jax, jax.numpy as jnp
from jax import lax
import numpy as np

D_MODEL = 1024
BATCH = 8
SEQ = 4096
DEPTH = 1

MIX_WIDTH = D_MODEL
FOURIER_WIDTH = MIX_WIDTH // 2
FOURIER_GROUPS = 8
FOURIER_GROUP_DIM = FOURIER_WIDTH // FOURIER_GROUPS
HYENA_WIDTH = MIX_WIDTH - FOURIER_WIDTH
HYENA_ORDER = 2
SHORT_CONV = 3
POS_BANDS = 16
POS_EMB_DIM = 1 + 2 * POS_BANDS
FILTER_HIDDEN = 64
FILTER_INNER_LAYERS = 2
N_DIRECTIONS = 2
IN_WIDTH = FOURIER_WIDTH + (HYENA_ORDER + 1) * HYENA_WIDTH
D_FF = 4 * D_MODEL
DECAY_TARGET = 1e-2
FAST_DECAY_PCT = 0.3
SLOW_DECAY_PCT = 1.5
MAX_DECAY = math.log(DECAY_TARGET) / FAST_DECAY_PCT
MIN_DECAY = math.log(DECAY_TARGET) / SLOW_DECAY_PCT
EPS = 1e-5

kernel_name = 'hybrid_fnet_hyena_parallel_block'


def rmsnorm(x, g):
    xf = x.astype(jnp.float32)
    y = xf * lax.rsqrt(jnp.mean(xf * xf, axis=-1, keepdims=True) + EPS)
    return (y * g.astype(jnp.float32)).astype(x.dtype)


def fourier_mix(u):
    b, l, _ = u.shape
    ug = u.astype(jnp.float32).reshape(b, l, FOURIER_GROUPS, FOURIER_GROUP_DIM)
    f = jnp.fft.fft2(ug, axes=(1, 3), norm='ortho').real
    return f.reshape(b, l, FOURIER_WIDTH).astype(u.dtype)


def short_conv(u, w, bias):
    l = u.shape[1]
    pad = SHORT_CONV // 2
    up = jnp.pad(u, ((0, 0), (pad, SHORT_CONV - 1 - pad), (0, 0)))
    y = up[:, 0:l] * w[0]
    for j in range(1, SHORT_CONV):
        y = y + up[:, j:j + l] * w[j]
    return y + bias


def positional_features(l):
    pos = jnp.arange(l, dtype=jnp.float32)
    t = pos / jnp.float32(max(l - 1, 1))
    bands = jnp.linspace(1e-4, POS_BANDS - 1, POS_BANDS, dtype=jnp.float32)
    ang = (2.0 * jnp.pi * pos / l)[:, None] * bands[None, :]
    z = jnp.concatenate([t[:, None], jnp.cos(ang), -jnp.sin(ang)], axis=-1)
    return z, t


def implicit_filters(l, w0, b0, w_inner, b_inner, freq, w_out):
    z, t = positional_features(l)
    f32 = jnp.float32
    fr = freq.astype(f32)
    h = jnp.sin(fr * (z @ w0.astype(f32) + b0.astype(f32)))
    for j in range(FILTER_INNER_LAYERS):
        h = jnp.sin(fr * (h @ w_inner[j].astype(f32) + b_inner[j].astype(f32)))
    h = (h @ w_out.astype(f32)).reshape(l, HYENA_ORDER, N_DIRECTIONS, HYENA_WIDTH)
    deltas = jnp.linspace(MIN_DECAY, MAX_DECAY, HYENA_WIDTH, dtype=f32)
    decay = jnp.exp(-t[:, None] * jnp.abs(deltas)[None, :])
    h = h * decay[:, None, None, :]
    h_fwd = h[:, :, 0]
    h_bwd = h[:, :, 1]
    k = jnp.concatenate([h_fwd[:1] + h_bwd[:1], h_fwd[1:], jnp.zeros_like(h_fwd[:1]),
                         h_bwd[1:][::-1]], axis=0)
    return k * lax.rsqrt(jnp.sum(k * k, axis=0, keepdims=True) + EPS)


def fft_long_conv(u, k_freq, d):
    l = u.shape[1]
    uf32 = u.astype(jnp.float32)
    uf = jnp.fft.rfft(uf32, n=2 * l, axis=1)
    y = jnp.fft.irfft(uf * k_freq[None], n=2 * l, axis=1)[:, :l]
    return (y + uf32 * d.astype(jnp.float32)).astype(u.dtype)


def hyena_mix(u, conv_w, conv_b, filt_w0, filt_b0, filt_w_inner, filt_b_inner, filt_freq,
              filt_w_out, long_d):
    l = u.shape[1]
    u = short_conv(u, conv_w, conv_b)
    x1, x2, v = jnp.split(u, HYENA_ORDER + 1, axis=-1)
    k = implicit_filters(l, filt_w0, filt_b0, filt_w_inner, filt_b_inner, filt_freq, filt_w_out)
    k_freq = jnp.fft.rfft(k, axis=0)
    z = v
    for n, gate in enumerate((x1, x2)):
        z = gate * fft_long_conv(z, k_freq[:, n], long_d[n])
    return z


def setup_inputs(seed: int = 0) -> dict:
    key = jax.random.key(seed)
    ks = jax.random.split(key, 20)
    f32 = jnp.float32

    def nrm(k, shape, scale):
        return jax.random.normal(k, shape, f32) * scale

    def gain(k, shape):
        return 1.0 + 0.02 * jax.random.normal(k, shape, f32)

    return {
        'x': jax.random.normal(ks[0], (BATCH, SEQ, D_MODEL), f32),
        'g_mix': gain(ks[1], (DEPTH, D_MODEL)),
        'w_in': nrm(ks[2], (DEPTH, D_MODEL, IN_WIDTH), D_MODEL ** -0.5),
        'conv_w': nrm(ks[3], (DEPTH, SHORT_CONV, (HYENA_ORDER + 1) * HYENA_WIDTH), SHORT_CONV ** -0.5),
        'conv_b': nrm(ks[4], (DEPTH, (HYENA_ORDER + 1) * HYENA_WIDTH), 0.01),
        'filt_w0': nrm(ks[5], (DEPTH, POS_EMB_DIM, FILTER_HIDDEN), POS_EMB_DIM ** -0.5),
        'filt_b0': nrm(ks[6], (DEPTH, FILTER_HIDDEN), 0.1),
        'filt_w_inner': nrm(ks[7], (DEPTH, FILTER_INNER_LAYERS, FILTER_HIDDEN, FILTER_HIDDEN), FILTER_HIDDEN ** -0.5),
        'filt_b_inner': nrm(ks[8], (DEPTH, FILTER_INNER_LAYERS, FILTER_HIDDEN), 0.1),
        'filt_freq': gain(ks[9], (DEPTH, FILTER_HIDDEN)),
        'filt_w_out': nrm(ks[10], (DEPTH, FILTER_HIDDEN, HYENA_ORDER * N_DIRECTIONS * HYENA_WIDTH), FILTER_HIDDEN ** -0.5),
        'long_d': nrm(ks[11], (DEPTH, HYENA_ORDER, HYENA_WIDTH), 0.1),
        'g_fourier': gain(ks[12], (DEPTH, FOURIER_WIDTH)),
        'g_hyena': gain(ks[13], (DEPTH, HYENA_WIDTH)),
        'w_out': nrm(ks[14], (DEPTH, MIX_WIDTH, D_MODEL), MIX_WIDTH ** -0.5),
        'g_mlp': gain(ks[15], (DEPTH, D_MODEL)),
        'w_fc1': nrm(ks[16], (DEPTH, D_MODEL, D_FF), D_MODEL ** -0.5),
        'w_fc2': nrm(ks[17], (DEPTH, D_FF, D_MODEL), D_FF ** -0.5),
        'g_final': gain(ks[18], (D_MODEL,)),
    }


def reference(x, g_mix, w_in, conv_w, conv_b, filt_w0, filt_b0, filt_w_inner, filt_b_inner,
              filt_freq, filt_w_out, long_d, g_fourier, g_hyena, w_out, g_mlp, w_fc1, w_fc2,
              g_final):
    for i in range(DEPTH):
        h = rmsnorm(x, g_mix[i])
        p = jnp.einsum('bld,de->ble', h, w_in[i])
        u_f = p[..., :FOURIER_WIDTH]
        u_h = p[..., FOURIER_WIDTH:]
        y_f = rmsnorm(fourier_mix(u_f), g_fourier[i])
        y_h = rmsnorm(hyena_mix(u_h, conv_w[i], conv_b[i], filt_w0[i], filt_b0[i], filt_w_inner[i],
                                filt_b_inner[i], filt_freq[i], filt_w_out[i], long_d[i]), g_hyena[i])
        y = jnp.concatenate([y_f, y_h], axis=-1)
        x = x + jnp.einsum('ble,ed->bld', y, w_out[i])
        hm = rmsnorm(x, g_mlp[i])
        a = jnp.square(jax.nn.relu(jnp.einsum('bld,df->blf', hm, w_fc1[i])))
        x = x + jnp.einsum('blf,fd->bld', a, w_fc2[i])
    return rmsnorm(x, g_final)
```

```cpp
#include <hip/hip_runtime.h>
#include <hip/hip_cooperative_groups.h>
#include <cstdio>
namespace cg = cooperative_groups;

#ifndef PHMASK
#define PHMASK 0x1ff
#endif
#ifndef N_LAUNCHES
#define N_LAUNCHES 9
#endif
#define LDSQ __attribute__((address_space(3)))
typedef unsigned short bf16_t;
typedef short bf16x8 __attribute__((ext_vector_type(8)));
typedef float f32x4 __attribute__((ext_vector_type(4)));
typedef unsigned u32x4 __attribute__((ext_vector_type(4)));
typedef unsigned u32x2 __attribute__((ext_vector_type(2)));

constexpr int NB = 8, SEQ = 4096, DM = 1024, NTOK = NB * SEQ, INW = 2048, DFF = 4096;
constexpr float EPSF = 1e-5f;
constexpr size_t MiB = 1024 * 1024;
constexpr size_t WS_H = 0, WS_PT = 64 * MiB, WS_YT = 192 * MiB, WS_Y = 256 * MiB, WS_A = 64 * MiB, WS_X1 = 320 * MiB,
                 WS_WIN = 448 * MiB, WS_WOUT = 452 * MiB, WS_W1 = 454 * MiB, WS_W2 = 462 * MiB, WS_HF = 470 * MiB, WS_END = 502 * MiB;
constexpr int LDS_BYTES = 139264;

__device__ __forceinline__ int opaque_tid() { int t = threadIdx.x; asm volatile("" : "+v"(t)); return t; }
namespace pg8 {
constexpr int BM = 256, BK = 64, HALF = 128, HTB = HALF * BK * 2, STAGE_BYTES = 8 * HTB, NXCD = 8, WGM = 8;
__host__ __device__ __forceinline__ int lds_byte(int r, int c) { const int st = (r >> 4) * 2 + (c >> 5), rr = r & 15, cc = c & 31, ob = rr * 64 + cc * 2; return st * 1024 + (ob ^ (((ob >> 9) & 1) << 5)); }
__host__ __device__ __forceinline__ void stage_rc(int b, int& R, int& C) { const int st = b / 1024, sb = b % 1024, swz = sb ^ (((sb >> 9) & 1) << 5); R = (st >> 1) * 16 + swz / 64; C = (st & 1) * 32 + (swz % 64) / 2; }
__host__ __device__ __forceinline__ int perm32(int rho) { const int n = rho >> 4, i = rho & 15; return 8 * (i >> 2) + 4 * n + (i & 3); }
struct Unit { int pm, pn; };
struct Gemm { const bf16_t* A; const bf16_t* Bt; int M, N, K; };
struct StaticOrder {
    int nM, nN, nwg, G, c;
    __host__ __device__ void init(int M, int N, int G_, int c_) { nM = M / BM; nN = N / BM; nwg = nM * nN; G = G_; c = c_; }
    __host__ __device__ bool next(int i, Unit& u) const {
        const long L = (long)i * G + c; if (L >= nwg) return false;
        int wgid = (int)L; { const int q = nwg / NXCD, r = nwg % NXCD, xcd = wgid % NXCD, off = wgid / NXCD; wgid = (xcd < r ? xcd * (q + 1) : r * (q + 1) + (xcd - r) * q) + off; }
        const int nig = WGM * nN, gid = wgid / nig, fm = gid * WGM, gsz = (nM - fm) < WGM ? (nM - fm) : WGM;
        u.pm = fm + ((wgid % nig) % gsz); u.pn = (wgid % nig) / gsz; return true;
    }
    __device__ __forceinline__ void a_ready(const Unit&) const {}
    __device__ __forceinline__ void done(const Unit&) const {}
};
__device__ __forceinline__ unsigned cvt_pk_bf16(float lo, float hi) { unsigned r; asm volatile("v_cvt_pk_bf16_f32 %0, %1, %2" : "=v"(r) : "v"(lo), "v"(hi)); return r; }

template <int ACT  > struct EpiBf16 {
    static constexpr bool PERM = true;
    bf16_t* O; int ldc;
    __device__ __forceinline__ void operator()(const f32x4 (&acc)[2][2][4][2], const Unit& u, int wr, int wc, int fr, int fq) const {
        const int row0 = u.pm * BM + wr * 64 + fr; const int col0 = u.pn * BM + wc * 32 + 8 * fq;
#pragma unroll
        for (int ai = 0; ai < 2; ++ai)
#pragma unroll
            for (int m = 0; m < 4; ++m) { bf16_t* rowp = O + (size_t)(row0 + ai * HALF + m * 16) * ldc + col0;
#pragma unroll
                for (int bj = 0; bj < 2; ++bj) { f32x4 v0 = acc[ai][bj][m][0], v1 = acc[ai][bj][m][1];
                    if (ACT == 1) {
#pragma unroll
                        for (int j = 0; j < 4; ++j) { const float a = fmaxf(v0[j], 0.f), b = fmaxf(v1[j], 0.f); v0[j] = a * a; v1[j] = b * b; } }
                    u32x4 w; w.x = cvt_pk_bf16(v0[0], v0[1]); w.y = cvt_pk_bf16(v0[2], v0[3]); w.z = cvt_pk_bf16(v1[0], v1[1]); w.w = cvt_pk_bf16(v1[2], v1[3]);
                    *(u32x4*)(rowp + bj * HALF) = w; } }
    }
};
struct EpiResF32 {
    static constexpr bool PERM = false;
    const float* R; float* C; int ldc;
    __device__ __forceinline__ void operator()(const f32x4 (&acc)[2][2][4][2], const Unit& u, int wr, int wc, int fr, int fq) const {
        const int row0 = u.pm * BM + wr * 64 + fr, col0 = u.pn * BM + wc * 32 + 4 * fq;
#pragma unroll
        for (int ai = 0; ai < 2; ++ai)
#pragma unroll
            for (int m = 0; m < 4; ++m) { const size_t ro = (size_t)(row0 + ai * HALF + m * 16) * ldc + col0;
#pragma unroll
                for (int bj = 0; bj < 2; ++bj)
#pragma unroll
                    for (int n = 0; n < 2; ++n) { const f32x4 r = *(const f32x4*)(R + ro + bj * HALF + n * 16); *(f32x4*)(C + ro + bj * HALF + n * 16) = acc[ai][bj][m][n] + r; } }
    }
};

template <class Epi, class Sched>
__device__ __forceinline__ void gemm_phase(LDSQ unsigned char* lds, const Gemm g, const Sched& S, const Epi& E) {
    const int tid = opaque_tid(), wid = __builtin_amdgcn_readfirstlane(tid >> 6), lane = tid & 63, wr = wid >> 2, wc = wid & 3, fr = lane & 15, fq = lane >> 4;
    const int K = g.K, nt = K / BK;
    unsigned voffA[2], voffB[2];
#pragma unroll
    for (int i = 0; i < 2; ++i) { int R, C; stage_rc(tid * 16 + i * 8192, R, C); const int Rb = Epi::PERM ? ((R & ~31) + perm32(R & 31)) : R;
        voffA[i] = (unsigned)(R * K + C) * 2u; voffB[i] = (unsigned)(Rb * K + C) * 2u; }
    const size_t kstep = (size_t)(BK * 2);
    const size_t hstep = (size_t)HALF * K * 2;
    const size_t tstep = 2 * hstep;
    const unsigned ldsw = (unsigned)wid * 1024u;
    const int aoff = lds_byte(wr * 64 + fr, fq * 8), boff = lds_byte(wc * 32 + fr, fq * 8);
#define PG8_SA(b, h) (((b) * 2 + (h)) * HTB)
#define PG8_SB(b, h) ((4 + (b) * 2 + (h)) * HTB)
#define PG8_STAGE(bufoff, gbase, voff) do { _Pragma("unroll") for (int _i = 0; _i < 2; ++_i) \
        __builtin_amdgcn_global_load_lds((const unsigned*)((const char*)(gbase) + (voff)[_i]), (LDSQ unsigned*)(lds + (bufoff) + ldsw + _i * 8192), 16, 0, 0); } while (0)
#define PG8_LDA(dst, b, h) do { _Pragma("unroll") for (int m = 0; m < 4; ++m) _Pragma("unroll") for (int k = 0; k < 2; ++k) dst[m][k] = *(const LDSQ bf16x8*)(lds + PG8_SA(b, h) + aoff + m * 2048 + k * 1024); } while (0)
#define PG8_LDB(dst, b, h) do { _Pragma("unroll") for (int n = 0; n < 2; ++n) _Pragma("unroll") for (int k = 0; k < 2; ++k) dst[n][k] = *(const LDSQ bf16x8*)(lds + PG8_SB(b, h) + boff + n * 2048 + k * 1024); } while (0)
#define PG8_MMA(ai, bj, At, Bt) do { __builtin_amdgcn_s_setprio(1); _Pragma("unroll") for (int m = 0; m < 4; ++m) _Pragma("unroll") for (int n = 0; n < 2; ++n) _Pragma("unroll") for (int k = 0; k < 2; ++k) \
        acc[ai][bj][m][n] = __builtin_amdgcn_mfma_f32_16x16x32_bf16(Bt[n][k], At[m][k], acc[ai][bj][m][n], 0, 0, 0); __builtin_amdgcn_s_setprio(0); } while (0)
#define PG8_WAIT_V(n) asm volatile("s_waitcnt vmcnt(" #n ")" ::: "memory")
#define PG8_WAIT_L(n) asm volatile("s_waitcnt lgkmcnt(" #n ")" ::: "memory")
#define PG8_BAR __builtin_amdgcn_s_barrier()
#define PG8_SCHED __builtin_amdgcn_sched_barrier(0)
    Unit cur, nxt; int ui = 0;
    if (!S.next(0, cur)) return;
    f32x4 acc[2][2][4][2];
#pragma unroll
    for (int a = 0; a < 2; ++a)
#pragma unroll
        for (int b = 0; b < 2; ++b)
#pragma unroll
            for (int m = 0; m < 4; ++m)
#pragma unroll
                for (int n = 0; n < 2; ++n) acc[a][b][m][n] = (f32x4){0.f, 0.f, 0.f, 0.f};
    bf16x8 At[4][2], B0[2][2], B1[2][2];
    const char* cA = (const char*)g.A + (size_t)cur.pm * tstep; const char* cB = (const char*)g.Bt + (size_t)cur.pn * tstep;
    S.a_ready(cur);
    PG8_STAGE(PG8_SB(0, 0), cB, voffB); PG8_STAGE(PG8_SA(0, 0), cA, voffA); PG8_STAGE(PG8_SB(0, 1), cB + hstep, voffB); PG8_STAGE(PG8_SA(0, 1), cA + hstep, voffA);
    if (wr == 1) PG8_BAR;
    PG8_WAIT_V(4); PG8_BAR;
    PG8_STAGE(PG8_SB(1, 0), cB + kstep, voffB); PG8_STAGE(PG8_SA(1, 0), cA + kstep, voffA); PG8_STAGE(PG8_SB(1, 1), cB + hstep + kstep, voffB);
    PG8_WAIT_V(6); PG8_BAR;
    for (;;) {
        const bool has_next = S.next(ui + 1, nxt);
        const char* nA = has_next ? (const char*)g.A + (size_t)nxt.pm * tstep : cA; const char* nB = has_next ? (const char*)g.Bt + (size_t)nxt.pn * tstep : cB;
        for (int t = 0; t < nt; t += 2) {
            const bool last = (t == nt - 2);
            const char* a1 = cA + (size_t)(t + 1) * kstep;
            const char* a2 = last ? nA : cA + (size_t)(t + 2) * kstep; const char* b2 = last ? nB : cB + (size_t)(t + 2) * kstep;
            const char* a3 = a2 + kstep; const char* b3 = b2 + kstep;
            if (last && has_next) S.a_ready(nxt);
            PG8_LDB(B0, 0, 0); PG8_SCHED; PG8_LDA(At, 0, 0); PG8_STAGE(PG8_SA(1, 1), a1 + hstep, voffA);
            PG8_WAIT_L(8); PG8_BAR; PG8_WAIT_L(0); PG8_MMA(0, 0, At, B0); PG8_BAR; PG8_SCHED;
            PG8_LDB(B1, 0, 1); PG8_STAGE(PG8_SB(0, 0), b2, voffB);
            PG8_BAR; PG8_WAIT_L(0); PG8_MMA(0, 1, At, B1); PG8_BAR;
            PG8_LDA(At, 0, 1); PG8_STAGE(PG8_SA(0, 0), a2, voffA);
            PG8_BAR; PG8_WAIT_L(0); PG8_MMA(1, 0, At, B0); PG8_BAR; PG8_SCHED;
            PG8_STAGE(PG8_SB(0, 1), b2 + hstep, voffB);
            PG8_WAIT_V(6); PG8_BAR; PG8_MMA(1, 1, At, B1); PG8_BAR;
            PG8_LDB(B0, 1, 0); PG8_SCHED; PG8_LDA(At, 1, 0); PG8_STAGE(PG8_SA(0, 1), a2 + hstep, voffA);
            PG8_WAIT_L(8); PG8_BAR; PG8_WAIT_L(0); PG8_MMA(0, 0, At, B0); PG8_BAR; PG8_SCHED;
            PG8_LDB(B1, 1, 1); PG8_STAGE(PG8_SB(1, 0), b3, voffB);
            PG8_BAR; PG8_WAIT_L(0); PG8_MMA(0, 1, At, B1); PG8_BAR;
            PG8_LDA(At, 1, 1); PG8_STAGE(PG8_SA(1, 0), a3, voffA);
            PG8_BAR; PG8_WAIT_L(0); PG8_MMA(1, 0, At, B0); PG8_BAR; PG8_SCHED;
            PG8_STAGE(PG8_SB(1, 1), b3 + hstep, voffB);
            PG8_WAIT_V(6); PG8_BAR; PG8_MMA(1, 1, At, B1); PG8_BAR;
        }
        E(acc, cur, wr, wc, fr, fq); S.done(cur);
        if (!has_next) break;
#pragma unroll
        for (int a = 0; a < 2; ++a)
#pragma unroll
            for (int b = 0; b < 2; ++b)
#pragma unroll
                for (int m = 0; m < 4; ++m)
#pragma unroll
                    for (int n = 0; n < 2; ++n) acc[a][b][m][n] = (f32x4){0.f, 0.f, 0.f, 0.f};
        cur = nxt; cA = nA; cB = nB; ++ui;
    }
    PG8_WAIT_V(0);
    if (wr == 0) PG8_BAR;
    PG8_BAR;
#undef PG8_SA
#undef PG8_SB
#undef PG8_STAGE
#undef PG8_LDA
#undef PG8_LDB
#undef PG8_MMA
#undef PG8_WAIT_V
#undef PG8_WAIT_L
#undef PG8_BAR
#undef PG8_SCHED
}
}

typedef float f2 __attribute__((ext_vector_type(2)));
#define HD __host__ __device__ __forceinline__

HD f2 cmul(f2 a, f2 b) { return (f2){a.x * b.x - a.y * b.y, a.x * b.y + a.y * b.x}; }
HD f2 cmulc(f2 a, f2 b) { return (f2){a.x * b.x + a.y * b.y, a.y * b.x - a.x * b.y}; }
HD f2 cconj(f2 a) { return (f2){a.x, -a.y}; }
HD f2 twid(float x) {
#ifdef __HIP_DEVICE_COMPILE__
    return (f2){cospif(x), -sinpif(x)};
#else
    return (f2){(float)cos(3.14159265358979323846 * (double)x), (float)-sin(3.14159265358979323846 * (double)x)};
#endif
}
HD constexpr int rev16(int i) { return (i >> 2) | ((i & 3) << 2); }
HD int phys(int p) { return p + (p >> 4); }

template <bool INV> HD void bfly4(f2& x0, f2& x1, f2& x2, f2& x3) {
    const f2 t0 = x0 + x2, t1 = x0 - x2, t2 = x1 + x3, t3 = x1 - x3;
    const f2 it3 = INV ? (f2){-t3.y, t3.x} : (f2){t3.y, -t3.x};
    x0 = t0 + t2; x1 = t1 + it3; x2 = t0 - t2; x3 = t1 - it3;
}
template <bool INV> HD f2 mulw(f2 z, float c, float s) {
    const float ss = INV ? s : -s;
    return (f2){z.x * c - z.y * ss, z.x * ss + z.y * c};
}
template <bool INV> HD void fft16(f2 (&v)[16]) {
#pragma unroll
    for (int j = 0; j < 4; ++j) bfly4<INV>(v[j], v[j + 4], v[j + 8], v[j + 12]);
    const float C1 = 0.92387953251128674f, S1 = 0.38268343236508977f, H = 0.70710678118654752f;
    v[5] = mulw<INV>(v[5], C1, S1);  v[9] = mulw<INV>(v[9], H, H);     v[13] = mulw<INV>(v[13], S1, C1);
    v[6] = mulw<INV>(v[6], H, H);    v[10] = mulw<INV>(v[10], 0.f, 1.f); v[14] = mulw<INV>(v[14], -H, H);
    v[7] = mulw<INV>(v[7], S1, C1);  v[11] = mulw<INV>(v[11], -H, H);  v[15] = mulw<INV>(v[15], -C1, -S1);
#pragma unroll
    for (int q = 0; q < 4; ++q) bfly4<INV>(v[4 * q], v[4 * q + 1], v[4 * q + 2], v[4 * q + 3]);
}
HD int opq(int t) {
#ifdef __HIP_DEVICE_COMPILE__
    asm volatile("" : "+v"(t));
#endif
    return t;
}
HD f2 opq2(f2 w) {
#ifdef __HIP_DEVICE_COMPILE__
    asm volatile("" : "+v"(w.x), "+v"(w.y));
#endif
    return w;
}
HD void tw_apply(f2 (&v)[16], f2 base, f2 w1) {
    w1 = opq2(w1); base = opq2(base);
    const f2 q2 = cmul(w1, w1), q4 = cmul(q2, q2), q8 = cmul(q4, q4);
    f2 p[16];
    p[0] = base; p[1] = cmul(base, w1); p[2] = cmul(p[0], q2); p[3] = cmul(p[1], q2);
#pragma unroll
    for (int e = 0; e < 4; ++e) p[4 + e] = cmul(p[e], q4);
#pragma unroll
    for (int e = 0; e < 8; ++e) p[8 + e] = cmul(p[e], q8);
#pragma unroll
    for (int i = 0; i < 16; ++i) v[i] = cmul(v[i], p[rev16(i)]);
}

struct FftTw { f2 w_p1, w_p2, b_i2, w_i2; };
HD FftTw make_tw(int t) {
    const int k0 = t >> 4, n0 = t & 15;
    FftTw w;
    w.w_p1 = twid((float)t * (1.0f / 2048.0f));
    w.w_p2 = twid((float)n0 * (1.0f / 128.0f));
    w.b_i2 = cconj(twid((float)(n0 * k0) * (1.0f / 2048.0f)));
    w.w_i2 = cconj(twid((float)k0 * (1.0f / 128.0f)));
    return w;
}
HD void f_p1(LDSQ f2* arr, int t, const FftTw& w) {
    t = opq(t) & 255;
    LDSQ f2* a = arr + (t + (t >> 4));
    f2 v[16];
#pragma unroll
    for (int i = 0; i < 16; ++i) v[i] = a[272 * i];
    fft16<false>(v); tw_apply(v, (f2){1.f, 0.f}, w.w_p1);
#pragma unroll
    for (int i = 0; i < 16; ++i) a[272 * rev16(i)] = v[i];
}
HD void f_p1_regs(LDSQ f2* arr, int t, const FftTw& w, f2 (&v)[16]) {
    t = opq(t) & 255;
    LDSQ f2* a = arr + (t + (t >> 4));
    fft16<false>(v); tw_apply(v, (f2){1.f, 0.f}, w.w_p1);
#pragma unroll
    for (int i = 0; i < 16; ++i) a[272 * rev16(i)] = v[i];
}
HD void f_p2(LDSQ f2* arr, int t, const FftTw& w) {
    t = opq(t) & 255;
    const int k0 = t >> 4, n0 = t & 15;
    LDSQ f2* a = arr + (272 * k0 + n0);
    f2 v[16];
#pragma unroll
    for (int i = 0; i < 16; ++i) v[i] = a[17 * i];
    fft16<false>(v); tw_apply(v, (f2){1.f, 0.f}, w.w_p2);
#pragma unroll
    for (int i = 0; i < 16; ++i) a[17 * rev16(i)] = v[i];
}
HD void f_p3(LDSQ f2* arr, int t, f2 (&v)[16]) {
    t = opq(t) & 255;
    LDSQ f2* a = arr + 17 * t;
#pragma unroll
    for (int i = 0; i < 16; ++i) v[i] = a[i];
    fft16<false>(v);
}
HD void i_p3(LDSQ f2* arr, int t, const FftTw& w, const f2 (&v)[16]) {
    t = opq(t) & 255;
    LDSQ f2* a = arr + 17 * t;
    f2 u[16];
#pragma unroll
    for (int i = 0; i < 16; ++i) u[rev16(i)] = v[i];
    fft16<true>(u);
    tw_apply(u, (f2){1.f, 0.f}, cconj(w.w_p2));
#pragma unroll
    for (int i = 0; i < 16; ++i) a[rev16(i)] = u[i];
}
HD void i_p2(LDSQ f2* arr, int t, const FftTw& w) {
    t = opq(t) & 255;
    const int k0 = t >> 4, n0 = t & 15;
    LDSQ f2* a = arr + (272 * k0 + n0);
    f2 u[16];
#pragma unroll
    for (int i = 0; i < 16; ++i) u[i] = a[17 * i];
    fft16<true>(u);
    tw_apply(u, w.b_i2, w.w_i2);
#pragma unroll
    for (int i = 0; i < 16; ++i) a[17 * rev16(i)] = u[i];
}
HD void i_p1(LDSQ f2* arr, int t) {
    t = opq(t) & 255;
    LDSQ f2* a = arr + (t + (t >> 4));
    f2 u[16];
#pragma unroll
    for (int i = 0; i < 16; ++i) u[i] = a[272 * i];
    fft16<true>(u);
#pragma unroll
    for (int i = 0; i < 16; ++i) a[272 * rev16(i)] = u[i];
}

__device__ __forceinline__ float bf2f(bf16_t b) { return __uint_as_float(((unsigned)b) << 16); }
__device__ __forceinline__ bf16_t f2bf(float f) { unsigned u = __float_as_uint(f); u += 0x7FFFu + ((u >> 16) & 1u); return (bf16_t)(u >> 16); }
__device__ __forceinline__ unsigned pack2(float lo, float hi) { return (unsigned)f2bf(lo) | ((unsigned)f2bf(hi) << 16); }
__device__ __forceinline__ float wave_sum(float v) {
#pragma unroll
    for (int o = 32; o > 0; o >>= 1) v += __shfl_xor(v, o, 64);
    return v;
}
__device__ __forceinline__ float sin_acc(float x) { return sinpif(x * 0.31830988618379067f); }

struct Params {
    const float* in[19];
    float* out;
    unsigned char* ws;
    int ph_lo, ph_hi;
};

__device__ __forceinline__ void transpose_w(const float* __restrict__ src, int K, int N, bf16_t* __restrict__ dst, int premix_cols, LDSQ float* tile, LDSQ float* cs) {
    const int tid = opaque_tid(), ntk = K / 64, ntn = N / 64;
    for (int tl = blockIdx.x; tl < ntk * ntn; tl += gridDim.x) {
        const int kt = tl % ntk, nt = tl / ntk, k0 = kt * 64, n0 = nt * 64;
        __syncthreads();
#pragma unroll
        for (int i = 0; i < 2; ++i) { const int q = tid + 512 * i, r = q >> 4, c4 = q & 15;
            const f32x4 v = *(const f32x4*)(src + (size_t)(k0 + r) * N + n0 + c4 * 4);
            tile[r * 65 + c4 * 4 + 0] = v[0]; tile[r * 65 + c4 * 4 + 1] = v[1]; tile[r * 65 + c4 * 4 + 2] = v[2]; tile[r * 65 + c4 * 4 + 3] = v[3]; }
        __syncthreads();
        const int n = tid & 63, kc = tid >> 6;
        float o[8];
        if (n0 < premix_cols) {
#pragma unroll
            for (int e = 0; e < 8; ++e) o[e] = 0.f;
#pragma unroll 2
            for (int c = 0; c < 64; ++c) {
                const float mcoef = (n <= 32) ? cs[(c * n) & 63] : -cs[64 + ((c * (n - 32)) & 63)];
#pragma unroll
                for (int e = 0; e < 8; ++e) o[e] += tile[(kc * 8 + e) * 65 + c] * mcoef;
            }
#pragma unroll
            for (int e = 0; e < 8; ++e) o[e] *= (1.0f / 512.0f);
        } else {
#pragma unroll
            for (int e = 0; e < 8; ++e) o[e] = tile[(kc * 8 + e) * 65 + n];
        }
        u32x4 w; w.x = pack2(o[0], o[1]); w.y = pack2(o[2], o[3]); w.z = pack2(o[4], o[5]); w.w = pack2(o[6], o[7]);
        *(u32x4*)(dst + (size_t)(n0 + n) * K + k0 + kc * 8) = w;
    }
}

template <bool OUT_BF16>
__device__ __forceinline__ void rmsnorm_rows(const float* X, const float* __restrict__ g, void* outp, int rows) {
    const int tid0 = opaque_tid(), lane = tid0 & 63, wid = tid0 >> 6;
    for (int row = blockIdx.x * 8 + wid; row < rows; row += gridDim.x * 8) {
        const f32x4* xr = (const f32x4*)(X + (size_t)row * DM);
        f32x4 v[4]; float ss = 0.f;
#pragma unroll
        for (int i = 0; i < 4; ++i) { v[i] = xr[lane + 64 * i]; ss += v[i][0] * v[i][0] + v[i][1] * v[i][1] + v[i][2] * v[i][2] + v[i][3] * v[i][3]; }
        ss = wave_sum(ss);
        const float rs = rsqrtf(ss * (1.0f / DM) + EPSF);
#pragma unroll
        for (int i = 0; i < 4; ++i) { const f32x4 gg = ((const f32x4*)g)[lane + 64 * i]; const f32x4 o = v[i] * rs * gg;
            if (OUT_BF16) { u32x2 w; w.x = pack2(o[0], o[1]); w.y = pack2(o[2], o[3]); *(u32x2*)((bf16_t*)outp + (size_t)row * DM + (lane + 64 * i) * 4) = w; }
            else *(f32x4*)((float*)outp + (size_t)row * DM + (lane + 64 * i) * 4) = o; }
    }
}

__device__ __forceinline__ void filter_mlp(const Params& P, float* __restrict__ hfilt, LDSQ float* lds) {
    const float* w0 = P.in[5]; const float* b0 = P.in[6]; const float* wi = P.in[7]; const float* bi = P.in[8]; const float* fr = P.in[9]; const float* wout = P.in[10];
    LDSQ float* zf = lds; LDSQ float* ha = lds + 544; LDSQ float* hb = ha + 1024;
    const int tid = opaque_tid();
    for (int blk = blockIdx.x; blk < SEQ / 16; blk += gridDim.x) {
        const int l0 = blk * 16;
        __syncthreads();
        for (int idx = tid; idx < 16 * 33; idx += 512) {
            const int l = idx / 33, f = idx - l * 33, pos = l0 + l; float val;
            if (f == 0) val = (float)pos / 4095.0f;
            else { const int j = (f - 1) & 15; const float band = 1e-4f + (float)j * ((15.0f - 1e-4f) / 15.0f); const float x = ((float)pos * (1.0f / 2048.0f)) * band;
                val = (f <= 16) ? cospif(x) : -sinpif(x); }
            zf[idx] = val;
        }
        __syncthreads();
#pragma unroll
        for (int r = 0; r < 2; ++r) { const int idx = tid + 512 * r, l = idx >> 6, u = idx & 63; float s = b0[u];
#pragma unroll 3
            for (int f = 0; f < 33; ++f) s += zf[l * 33 + f] * w0[f * 64 + u];
            ha[idx] = sin_acc(fr[u] * s); }
        __syncthreads();
#pragma unroll
        for (int r = 0; r < 2; ++r) { const int idx = tid + 512 * r, l = idx >> 6, u = idx & 63; float s = bi[u];
#pragma unroll 4
            for (int i = 0; i < 64; ++i) s += ha[l * 64 + i] * wi[i * 64 + u];
            hb[idx] = sin_acc(fr[u] * s); }
        __syncthreads();
#pragma unroll
        for (int r = 0; r < 2; ++r) { const int idx = tid + 512 * r, l = idx >> 6, u = idx & 63; float s = bi[64 + u];
#pragma unroll 4
            for (int i = 0; i < 64; ++i) s += hb[l * 64 + i] * wi[4096 + i * 64 + u];
            ha[idx] = sin_acc(fr[u] * s); }
        __syncthreads();
#pragma unroll 1
        for (int r = 0; r < 4; ++r) {
            const int col = tid + 512 * r; float acc[16];
#pragma unroll
            for (int l = 0; l < 16; ++l) acc[l] = 0.f;
#pragma unroll 2
            for (int i = 0; i < 64; ++i) { const float w = wout[i * 2048 + col];
#pragma unroll
                for (int l = 0; l < 16; ++l) acc[l] += ha[l * 64 + i] * w; }
            const int c = col & 511;
            const float dmin = -3.0701134573253945f, dmax = -15.350567286626973f;
            const float delta = fabsf(dmin + (float)c * ((dmax - dmin) / 511.0f));
#pragma unroll
            for (int l = 0; l < 16; ++l) acc[l] *= expf(-((float)(l0 + l) / 4095.0f) * delta);
            float* dst = hfilt + (size_t)col * SEQ + l0;
#pragma unroll
            for (int q = 0; q < 4; ++q) *(f32x4*)(dst + 4 * q) = (f32x4){acc[4 * q], acc[4 * q + 1], acc[4 * q + 2], acc[4 * q + 3]};
        }
    }
}

__device__ __forceinline__ float sconv(const bf16_t* __restrict__ p, int tl, int j, float w0, float w1, float w2, float bias) {
    const int n = tl + 512 * j;
    const float c = bf2f(p[n]); float l, r;
    if (j == 0) { l = bf2f(p[n > 0 ? n - 1 : 0]); l = n > 0 ? l : 0.f; } else l = bf2f(p[n - 1]);
    if (j == 7) { r = bf2f(p[n < SEQ - 1 ? n + 1 : n]); r = n < SEQ - 1 ? r : 0.f; } else r = bf2f(p[n + 1]);
    return w0 * l + w1 * c + w2 * r + bias;
}
__device__ __forceinline__ void conv4096(LDSQ f2* arr, int t, const FftTw& w, const f2 (&K)[16]) {
    f_p1(arr, t, w); __syncthreads(); f_p2(arr, t, w); __syncthreads();
    f2 v[16]; f_p3(arr, t, v);
#pragma unroll
    for (int i = 0; i < 16; ++i) v[i] = cmul(v[i], K[i]);
    i_p3(arr, t, w, v); __syncthreads(); i_p2(arr, t, w); __syncthreads(); i_p1(arr, t); __syncthreads();
}
__device__ __forceinline__ void conv4096_lds(LDSQ f2* arr, int t, const FftTw& w, const LDSQ f2* Kl  ) {
    f_p1(arr, t, w); __syncthreads(); f_p2(arr, t, w); __syncthreads();
    f2 v[16]; f_p3(arr, t, v);
#pragma unroll
    for (int i = 0; i < 16; ++i) v[i] = cmul(v[i], Kl[512 * i]);
    i_p3(arr, t, w, v); __syncthreads(); i_p2(arr, t, w); __syncthreads(); i_p1(arr, t); __syncthreads();
}
__device__ __forceinline__ void filter_spec(const float* __restrict__ hf, const float* __restrict__ hb, float dskip, LDSQ f2* E, LDSQ f2* O, LDSQ float* red, LDSQ f2* arr, int tid, int t, const FftTw& w, f2 wt, f2 (&K)[16]) {
    const f2 W16 = (f2){0.92387953251128674f, -0.38268343236508977f};
    const int tl = opq(tid) & 511, pe = tl + (tl >> 4);
    float ss = 0.f; f2 tw = opq2(wt);
#pragma unroll
    for (int j = 0; j < 8; ++j) { const int n = tl + 512 * j;
        const float f = hf[n], b = hb[(SEQ - n) & (SEQ - 1)];
        const float ke = f + b; float ko = f - b; ss += f * f + b * b;
        if (j == 0) { ko = n == 0 ? ke : ko; ss += n == 0 ? 2.f * f * b : 0.f; }
        E[pe + 544 * j] = (f2){ke, 0.f}; O[pe + 544 * j] = (f2){ko * tw.x, ko * tw.y}; tw = cmul(tw, W16); }
    ss = wave_sum(ss);
    if ((tl & 63) == 0) red[tl >> 6] = ss;
    __syncthreads();
    float tot = 0.f;
#pragma unroll
    for (int q = 0; q < 8; ++q) tot += red[q];
    f_p1(arr, t, w); __syncthreads(); f_p2(arr, t, w); __syncthreads();
    f2 v[16]; f_p3(arr, t, v);
    const float scale = rsqrtf(tot + EPSF) * (1.0f / 8192.0f); const float dk = dskip * (1.0f / 8192.0f);
#pragma unroll
    for (int i = 0; i < 16; ++i) K[i] = (f2){v[i].x * scale + dk, v[i].y * scale};
    __syncthreads();
}
__device__ __forceinline__ void fft_phase(const Params& P, LDSQ unsigned char* lds) {
    const bf16_t* __restrict__ pT = (const bf16_t*)(P.ws + WS_PT); bf16_t* __restrict__ yT = (bf16_t*)(P.ws + WS_YT);
    const float* __restrict__ hfilt = (const float*)(P.ws + WS_HF);
    const float* conv_w = P.in[3]; const float* conv_b = P.in[4]; const float* long_d = P.in[11];
    LDSQ f2* E = (LDSQ f2*)lds; LDSQ f2* O = E + 4352; LDSQ float* red = (LDSQ float*)(O + 4352); LDSQ f2* K1l = (LDSQ f2*)(red + 16);
    const int tid = opaque_tid(), team = tid >> 8, t = tid & 255;
    LDSQ f2* arr = team ? O : E;
    const f2 wt = twid((float)tid * (1.0f / 4096.0f));
    const FftTw w = make_tw(t);
    const f2 W16 = (f2){0.92387953251128674f, -0.38268343236508977f};
#pragma unroll 1
    for (int c = blockIdx.x; c < 512; c += gridDim.x) {
        const float w1a = conv_w[c], w1b = conv_w[1536 + c], w1c = conv_w[3072 + c], b1 = conv_b[c];
        const float w2a = conv_w[512 + c], w2b = conv_w[1536 + 512 + c], w2c = conv_w[3072 + 512 + c], b2 = conv_b[512 + c];
        const float wva = conv_w[1024 + c], wvb = conv_w[1536 + 1024 + c], wvc = conv_w[3072 + 1024 + c], bv = conv_b[1024 + c];
        f2 K0[16];
        filter_spec(hfilt + (size_t)(2 * 512 + c) * SEQ, hfilt + (size_t)(3 * 512 + c) * SEQ, long_d[512 + c], E, O, red, arr, tid, t, w, wt, K0);
        { LDSQ f2* kl = K1l + (opq(tid) & 511);
#pragma unroll
          for (int i = 0; i < 16; ++i) kl[512 * i] = K0[i]; }
        filter_spec(hfilt + (size_t)(0 * 512 + c) * SEQ, hfilt + (size_t)(1 * 512 + c) * SEQ, long_d[c], E, O, red, arr, tid, t, w, wt, K0);
        const bf16_t* px1 = pT + (size_t)(512 + c) * NTOK; const bf16_t* px2 = pT + (size_t)(1024 + c) * NTOK; const bf16_t* pv = pT + (size_t)(1536 + c) * NTOK;
        bf16_t* yo = yT + (size_t)(512 + c) * NTOK;
#pragma unroll 1
        for (int pr = 0; pr < 4; ++pr) {
            const int o1 = (2 * pr) * SEQ, o2 = (2 * pr + 1) * SEQ;
            { const int tl = opq(tid) & 511, pe = tl + (tl >> 4); f2 tw = opq2(wt);
#pragma unroll
              for (int j = 0; j < 8; ++j) {
                const f2 z = (f2){sconv(pv + o1, tl, j, wva, wvb, wvc, bv), sconv(pv + o2, tl, j, wva, wvb, wvc, bv)};
                E[pe + 544 * j] = z; O[pe + 544 * j] = cmul(z, tw); tw = cmul(tw, W16); } }
            __syncthreads();
            conv4096(arr, t, w, K0);
            { const int tl = opq(tid) & 511, pe = tl + (tl >> 4); f2 tw = opq2(wt);
#pragma unroll
              for (int j = 0; j < 8; ++j) {
                const f2 y = E[pe + 544 * j] + cmulc(O[pe + 544 * j], tw);
                const f2 g = (f2){sconv(px1 + o1, tl, j, w1a, w1b, w1c, b1), sconv(px1 + o2, tl, j, w1a, w1b, w1c, b1)};
                const f2 z = g * y;
                E[pe + 544 * j] = z; O[pe + 544 * j] = cmul(z, tw); tw = cmul(tw, W16); } }
            __syncthreads();
            conv4096_lds(arr, t, w, K1l + (opq(tid) & 511));
            { const int tl = opq(tid) & 511, pe = tl + (tl >> 4); f2 tw = opq2(wt);
#pragma unroll
              for (int j = 0; j < 8; ++j) { const int n = tl + 512 * j;
                const f2 y = E[pe + 544 * j] + cmulc(O[pe + 544 * j], tw);
                const f2 g = (f2){sconv(px2 + o1, tl, j, w2a, w2b, w2c, b2), sconv(px2 + o2, tl, j, w2a, w2b, w2c, b2)};
                const f2 z = g * y;
                yo[o1 + n] = f2bf(z.x); yo[o2 + n] = f2bf(z.y); tw = cmul(tw, W16); } }
        }
    }
    __syncthreads();
#pragma unroll 1
    for (int J0 = blockIdx.x * 2; J0 < 2048; J0 += gridDim.x * 2) {
        const int J = J0 + team, b = J >> 8, g = (J >> 5) & 7, mm = J & 31;
        const bf16_t* pre = pT + (size_t)(g * 64 + mm) * NTOK + b * SEQ; const bf16_t* pim = pT + (size_t)(g * 64 + 32 + mm) * NTOK + b * SEQ;
        f2 v[16];
        { const int tq = opq(t) & 255;
#pragma unroll
          for (int i = 0; i < 16; ++i) v[i] = (f2){bf2f(pre[256 * i + tq]), bf2f(pim[256 * i + tq])}; }
        f_p1_regs(arr, t, w, v); __syncthreads(); f_p2(arr, t, w); __syncthreads(); f_p3(arr, t, v); __syncthreads();
        { const int tq = opq(t) & 255; LDSQ f2* a = arr + ((tq >> 4) + 17 * (tq & 15));
#pragma unroll
          for (int i = 0; i < 16; ++i) a[272 * rev16(i)] = v[i]; }
        __syncthreads();
        bf16_t* q1 = yT + (size_t)(g * 64 + mm) * NTOK + b * SEQ; bf16_t* q2 = yT + (size_t)(g * 64 + (mm ? 64 - mm : 32)) * NTOK + b * SEQ;
        { const int tq = opq(t) & 255, tr = 256 - tq;
          LDSQ f2* af = arr + (tq + (tq >> 4)); LDSQ f2* ar = arr + (tr + (tr >> 4));
#pragma unroll
          for (int j = 0; j < 16; ++j) { const int k = tq + 256 * j;
            const f2 a = af[272 * j]; f2 r = ar[272 * (15 - j)];
            if (j == 0) r = tq == 0 ? a : r;
            if (mm) { q1[k] = f2bf(a.x); q2[k] = f2bf(r.x); } else { q1[k] = f2bf(0.5f * (a.x + r.x)); q2[k] = f2bf(0.5f * (a.y + r.y)); } } }
        __syncthreads();
    }
}

__device__ __forceinline__ void transpose_norm(const Params& P, LDSQ unsigned char* lds) {
    const bf16_t* __restrict__ yT = (const bf16_t*)(P.ws + WS_YT); bf16_t* __restrict__ y = (bf16_t*)(P.ws + WS_Y);
    const float* gf = P.in[12]; const float* gh = P.in[13];
    const int tid = opaque_tid(), lane = tid & 63, wid = tid >> 6;
    for (int tl = blockIdx.x; tl < NTOK / 64; tl += gridDim.x) {
        const int tok0 = tl * 64;
        __syncthreads();
#pragma unroll 4
        for (int i = 0; i < 16; ++i) { const int q = tid + 512 * i, ch = q >> 3, part = q & 7;
            const u32x4 v = *(const u32x4*)(yT + (size_t)ch * NTOK + tok0 + part * 8);
            LDSQ unsigned* d = (LDSQ unsigned*)(lds + ch * 132 + part * 16); d[0] = v.x; d[1] = v.y; d[2] = v.z; d[3] = v.w; }
        __syncthreads();
        for (int tk = wid * 8; tk < wid * 8 + 8; ++tk) {
            float va[8], vb[8]; float ssf = 0.f, ssh = 0.f;
#pragma unroll
            for (int e = 0; e < 8; ++e) { const int ch = 2 * lane + 128 * e;
                va[e] = bf2f(*(const LDSQ bf16_t*)(lds + ch * 132 + tk * 2)); vb[e] = bf2f(*(const LDSQ bf16_t*)(lds + (ch + 1) * 132 + tk * 2));
                if (e < 4) ssf += va[e] * va[e] + vb[e] * vb[e]; else ssh += va[e] * va[e] + vb[e] * vb[e]; }
            ssf = wave_sum(ssf); ssh = wave_sum(ssh);
            const float rf = rsqrtf(ssf * (1.0f / 512.0f) + EPSF), rh = rsqrtf(ssh * (1.0f / 512.0f) + EPSF);
#pragma unroll
            for (int e = 0; e < 8; ++e) { const int ch = 2 * lane + 128 * e;
                const float g0 = e < 4 ? gf[ch] : gh[ch - 512], g1 = e < 4 ? gf[ch + 1] : gh[ch + 1 - 512], r = e < 4 ? rf : rh;
                *(unsigned*)(y + (size_t)(tok0 + tk) * DM + ch) = pack2(va[e] * r * g0, vb[e] * r * g1); }
        }
    }
}

__global__ __launch_bounds__(512, 2) void hybrid_fwd(Params P) {
    extern __shared__ __attribute__((aligned(16))) unsigned char shm[];
    LDSQ unsigned char* lds = (LDSQ unsigned char*)shm;
    cg::grid_group grid = cg::this_grid();
    unsigned char* ws = P.ws;
    for (int ph = P.ph_lo; ph < P.ph_hi; ++ph) {
        if (ph > P.ph_lo) grid.sync();
        if (ph == 0 && ((PHMASK >> 0) & 1)) {
            LDSQ float* tile = (LDSQ float*)lds; LDSQ float* cs = tile + 64 * 65;
            { const int tq = opaque_tid(); if (tq < 64) { cs[tq] = cospif((float)tq * (1.0f / 32.0f)); cs[64 + tq] = sinpif((float)tq * (1.0f / 32.0f)); } }
            __syncthreads();
            transpose_w(P.in[2], DM, INW, (bf16_t*)(ws + WS_WIN), 512, tile, cs);
            transpose_w(P.in[14], DM, DM, (bf16_t*)(ws + WS_WOUT), 0, tile, cs);
            transpose_w(P.in[16], DM, DFF, (bf16_t*)(ws + WS_W1), 0, tile, cs);
            transpose_w(P.in[17], DFF, DM, (bf16_t*)(ws + WS_W2), 0, tile, cs);
            __syncthreads();
            filter_mlp(P, (float*)(ws + WS_HF), (LDSQ float*)lds);
            rmsnorm_rows<true>(P.in[0], P.in[1], ws + WS_H, NTOK);
        } else if (ph == 1 && ((PHMASK >> 1) & 1)) {
            pg8::StaticOrder S; S.init(INW, NTOK, gridDim.x, blockIdx.x);
            pg8::gemm_phase(lds, pg8::Gemm{(const bf16_t*)(ws + WS_WIN), (const bf16_t*)(ws + WS_H), INW, NTOK, DM}, S, pg8::EpiBf16<0>{(bf16_t*)(ws + WS_PT), NTOK});
        } else if (ph == 2 && ((PHMASK >> 2) & 1)) {
            fft_phase(P, lds);
        } else if (ph == 3 && ((PHMASK >> 3) & 1)) {
            transpose_norm(P, lds);
        } else if (ph == 4 && ((PHMASK >> 4) & 1)) {
            pg8::StaticOrder S; S.init(NTOK, DM, gridDim.x, blockIdx.x);
            pg8::gemm_phase(lds, pg8::Gemm{(const bf16_t*)(ws + WS_Y), (const bf16_t*)(ws + WS_WOUT), NTOK, DM, DM}, S, pg8::EpiResF32{P.in[0], (float*)(ws + WS_X1), DM});
        } else if (ph == 5 && ((PHMASK >> 5) & 1)) {
            rmsnorm_rows<true>((const float*)(ws + WS_X1), P.in[15], ws + WS_H, NTOK);
        } else if (ph == 6 && ((PHMASK >> 6) & 1)) {
            pg8::StaticOrder S; S.init(NTOK, DFF, gridDim.x, blockIdx.x);
            pg8::gemm_phase(lds, pg8::Gemm{(const bf16_t*)(ws + WS_H), (const bf16_t*)(ws + WS_W1), NTOK, DFF, DM}, S, pg8::EpiBf16<1>{(bf16_t*)(ws + WS_A), DFF});
        } else if (ph == 7 && ((PHMASK >> 7) & 1)) {
            pg8::StaticOrder S; S.init(NTOK, DM, gridDim.x, blockIdx.x);
            pg8::gemm_phase(lds, pg8::Gemm{(const bf16_t*)(ws + WS_A), (const bf16_t*)(ws + WS_W2), NTOK, DM, DFF}, S, pg8::EpiResF32{(const float*)(ws + WS_X1), P.out, DM});
        } else if (ph == 8 && ((PHMASK >> 8) & 1)) {
            rmsnorm_rows<false>(P.out, P.in[18], P.out, NTOK);
        }
    }
}

extern "C" void kernel_launch(void* const* d_in, const int* in_sizes, int n_in, void* d_out, int out_size, void* d_ws, size_t ws_size, hipStream_t stream) {
    static int grid = 0;
    if (grid == 0) {
        if (n_in != 19 || in_sizes[0] != NTOK * DM || out_size != NTOK * DM || ws_size < WS_END) { fprintf(stderr, "kernel_launch: unexpected shapes (n_in %d, in0 %d, out %d, ws %zu)\n", n_in, n_in > 0 ? in_sizes[0] : -1, out_size, ws_size); grid = -1; return; }
        int dev = 0, cus = 0, per_cu = 0;
        hipGetDevice(&dev); hipDeviceGetAttribute(&cus, hipDeviceAttributeMultiprocessorCount, dev);
        if (hipFuncSetAttribute((const void*)hybrid_fwd, hipFuncAttributeMaxDynamicSharedMemorySize, LDS_BYTES) != hipSuccess) { fprintf(stderr, "kernel_launch: hipFuncSetAttribute failed\n"); grid = -1; return; }
        if (hipOccupancyMaxActiveBlocksPerMultiprocessor(&per_cu, (const void*)hybrid_fwd, 512, LDS_BYTES) != hipSuccess || per_cu < 1) { fprintf(stderr, "kernel_launch: occupancy query gave %d\n", per_cu); per_cu = 1; }
        (void)hipGetLastError();
        grid = cus;
    }
    if (grid < 0) return;
    Params p{};
    for (int i = 0; i < 19; ++i) p.in[i] = (const float*)d_in[i];
    p.out = (float*)d_out; p.ws = (unsigned char*)d_ws;
    constexpr int NPH = 9;
    for (int li = 0; li < N_LAUNCHES; ++li) {
        p.ph_lo = (N_LAUNCHES == 1) ? 0 : li; p.ph_hi = (N_LAUNCHES == 1) ? NPH : li + 1;
        void* args[] = {&p};
        hipError_t e = hipLaunchCooperativeKernel((const void*)hybrid_fwd, dim3(grid), dim3(512), args, LDS_BYTES, stream);
        if (e != hipSuccess) { fprintf(stderr, "kernel_launch: cooperative launch %d failed: %s (grid %d)\n", li, hipGetErrorString(e), grid); break; }
    }
}
```

```cpp
#include <hip/hip_runtime.h>
#include <hip/hip_cooperative_groups.h>
#include <cstdio>
namespace cg = cooperative_groups;

#ifndef N_LAUNCHES
#define N_LAUNCHES 1
#endif
#define LDSQ __attribute__((address_space(3)))
typedef unsigned short bf16_t;
typedef short bf16x8 __attribute__((ext_vector_type(8)));
typedef float f32x4 __attribute__((ext_vector_type(4)));
typedef unsigned u32x4 __attribute__((ext_vector_type(4)));
typedef unsigned u32x2 __attribute__((ext_vector_type(2)));

constexpr int NB = 8, SEQ = 4096, DM = 1024, NTOK = NB * SEQ, INW = 2048, DFF = 4096;
constexpr float EPSF = 1e-5f;
constexpr size_t MiB = 1024 * 1024;
constexpr size_t WS_H = 384 * MiB, WS_PT = 64 * MiB, WS_YT = 192 * MiB, WS_Y = 256 * MiB, WS_A = 64 * MiB, WS_X1 = 320 * MiB,
                 WS_WIN = 448 * MiB, WS_WOUT = 452 * MiB, WS_W1 = 454 * MiB, WS_W2 = 462 * MiB, WS_HF = 470 * MiB, WS_BAR = 502 * MiB, WS_SS1 = 503 * MiB, WS_SS2 = 505 * MiB, WS_END = 507 * MiB;
constexpr size_t WS_X2 = 0;
constexpr int LDS_XB = 139264;
constexpr int LDS_BYTES = LDS_XB + 16;


#define XB_TMO      128
#define XB_XCNT(j)  (256  + 64 * (j))
#define XB_XSUB(j)  (1280 + 64 * (j))
#define XB_XGEN(j)  (2304 + 64 * (j))
#define XB_TOP      3328
#define XB_TOPGEN   3392
#define XCD_BAR_WORDS 3456
#define XB_SPIN_CAP (1u << 22)
__device__ __forceinline__ unsigned xb_ld(unsigned* p)              { return __hip_atomic_load(p, __ATOMIC_RELAXED, __HIP_MEMORY_SCOPE_AGENT); }
__device__ __forceinline__ unsigned xb_add(unsigned* p, unsigned v) { return __hip_atomic_fetch_add(p, v, __ATOMIC_RELAXED, __HIP_MEMORY_SCOPE_AGENT); }
__device__ __forceinline__ unsigned xb_xcc_id() { return (unsigned)__builtin_amdgcn_s_getreg((3 << 11) | 20) & 0xFu; }
#define XB_SPIN(cond, bar) do { unsigned _sp = 0; while (cond) { __builtin_amdgcn_s_sleep(1); \
    if ((++_sp & 255u) == 0u) { if (xb_ld(&(bar)[XB_TMO])) break; if (_sp > XB_SPIN_CAP) { atomicAdd(&(bar)[XB_TMO], 1u); break; } } } } while (0)
struct XcdBarrier { unsigned* bar; unsigned x; volatile LDSQ unsigned* st; };
__device__ __forceinline__ XcdBarrier xcd_barrier_post(unsigned* bar, volatile LDSQ unsigned* st) {
    XcdBarrier b; b.bar = bar; b.x = xb_xcc_id(); b.st = st;
    if (threadIdx.x == 0) (void)xb_add(&bar[XB_XCNT(b.x)], 1u);
    return b;
}
__device__ __forceinline__ void xcd_barrier_complete(unsigned* bar, unsigned x, unsigned& nloc, unsigned& nx) {
    const unsigned G = gridDim.x * gridDim.y * gridDim.z;
    unsigned sum, cnt, mine, sp = 0u;
    for (;;) {
        sum = 0u; cnt = 0u; mine = 0u;
#pragma unroll
        for (unsigned j = 0; j < 16; ++j) { const unsigned c = xb_ld(&bar[XB_XCNT(j)]); sum += c; cnt += (c > 0u) ? 1u : 0u; mine = (j == x) ? c : mine; }
        if (sum == G) break;
        __builtin_amdgcn_s_sleep(1);
        if ((++sp & 255u) == 0u) { if (xb_ld(&bar[XB_TMO])) break; if (sp > XB_SPIN_CAP) { atomicAdd(&bar[XB_TMO], 1u); break; } }
    }
    nloc = mine > 0u ? mine : 1u; nx = cnt > 0u ? cnt : 1u;
}
__device__ __forceinline__ void xcd_barrier(const XcdBarrier& b) {
    asm volatile("s_waitcnt vmcnt(0)" ::: "memory");
    __syncthreads();
    if (threadIdx.x == 0) {
        unsigned* bar = b.bar;
        __builtin_amdgcn_s_waitcnt(0);
        unsigned nloc = b.st[0], nx = b.st[1];
        if (nloc == 0u) { xcd_barrier_complete(bar, b.x, nloc, nx); b.st[0] = nloc; b.st[1] = nx; }
        const unsigned old = xb_add(&bar[XB_XSUB(b.x)], 1u);
        const unsigned gen = old / nloc;
        if (old + 1u == (gen + 1u) * nloc) {
            __builtin_amdgcn_fence(__ATOMIC_RELEASE, "agent");
            asm volatile("s_waitcnt vmcnt(0)" ::: "memory");
            const unsigned og = xb_add(&bar[XB_TOP], 1u);
            const unsigned tg = og / nx;
            if (og + 1u == (tg + 1u) * nx) xb_add(&bar[XB_TOPGEN], 1u);
            else XB_SPIN(xb_ld(&bar[XB_TOPGEN]) == tg, bar);
            __builtin_amdgcn_fence(__ATOMIC_ACQUIRE, "agent");
            xb_add(&bar[XB_XGEN(b.x)], 1u);
            asm volatile("s_waitcnt vmcnt(0)" ::: "memory");
        } else {
            XB_SPIN(xb_ld(&bar[XB_XGEN(b.x)]) == gen, bar);
            __builtin_amdgcn_fence(__ATOMIC_ACQUIRE, "agent");
            asm volatile("s_waitcnt vmcnt(0)" ::: "memory");
        }
    }
    __syncthreads();
}

__device__ __forceinline__ int opaque_tid() { int t = threadIdx.x; asm volatile("" : "+v"(t)); return t; }
namespace pg8 {
constexpr int BM = 256, BK = 64, HALF = 128, HTB = HALF * BK * 2, STAGE_BYTES = 8 * HTB, NXCD = 8, WGM = 8;
__host__ __device__ __forceinline__ int lds_byte(int r, int c) { const int st = (r >> 4) * 2 + (c >> 5), rr = r & 15, cc = c & 31, ob = rr * 64 + cc * 2; return st * 1024 + (ob ^ (((ob >> 9) & 1) << 5)); }
__host__ __device__ __forceinline__ void stage_rc(int b, int& R, int& C) { const int st = b / 1024, sb = b % 1024, swz = sb ^ (((sb >> 9) & 1) << 5); R = (st >> 1) * 16 + swz / 64; C = (st & 1) * 32 + (swz % 64) / 2; }
__host__ __device__ __forceinline__ int perm32(int rho) { const int n = rho >> 4, i = rho & 15; return 8 * (i >> 2) + 4 * n + (i & 3); }
struct Unit { int pm, pn; };
struct Gemm { const bf16_t* A; const bf16_t* Bt; int M, N, K; };
struct StaticOrder {
    int nM, nN, nwg, G, c;
    __host__ __device__ void init(int M, int N, int G_, int c_) { nM = M / BM; nN = N / BM; nwg = nM * nN; G = G_; c = c_; }
    __host__ __device__ bool next(int i, Unit& u) const {
        const long L = (long)i * G + c; if (L >= nwg) return false;
        int wgid = (int)L; { const int q = nwg / NXCD, r = nwg % NXCD, xcd = wgid % NXCD, off = wgid / NXCD; wgid = (xcd < r ? xcd * (q + 1) : r * (q + 1) + (xcd - r) * q) + off; }
        const int nig = WGM * nN, gid = wgid / nig, fm = gid * WGM, gsz = (nM - fm) < WGM ? (nM - fm) : WGM;
        u.pm = fm + ((wgid % nig) % gsz); u.pn = (wgid % nig) / gsz; return true;
    }
    __device__ __forceinline__ void a_ready(const Unit&) const {}
    __device__ __forceinline__ void done(const Unit&) const {}
};
__device__ __forceinline__ unsigned cvt_pk_bf16(float lo, float hi) { unsigned r; asm volatile("v_cvt_pk_bf16_f32 %0, %1, %2" : "=v"(r) : "v"(lo), "v"(hi)); return r; }

template <int ACT  > struct EpiBf16 {
    static constexpr bool PERM = true;
    bf16_t* O; int ldc;
    __device__ __forceinline__ void operator()(const f32x4 (&acc)[2][2][4][2], const Unit& u, int wr, int wc, int fr, int fq) const {
        const int row0 = u.pm * BM + wr * 64 + fr; const int col0 = u.pn * BM + wc * 32 + 8 * fq;
#pragma unroll
        for (int ai = 0; ai < 2; ++ai)
#pragma unroll
            for (int m = 0; m < 4; ++m) { bf16_t* rowp = O + (size_t)(row0 + ai * HALF + m * 16) * ldc + col0;
#pragma unroll
                for (int bj = 0; bj < 2; ++bj) { f32x4 v0 = acc[ai][bj][m][0], v1 = acc[ai][bj][m][1];
                    if (ACT == 1) {
#pragma unroll
                        for (int j = 0; j < 4; ++j) { const float a = fmaxf(v0[j], 0.f), b = fmaxf(v1[j], 0.f); v0[j] = a * a; v1[j] = b * b; } }
                    u32x4 w; w.x = cvt_pk_bf16(v0[0], v0[1]); w.y = cvt_pk_bf16(v0[2], v0[3]); w.z = cvt_pk_bf16(v1[0], v1[1]); w.w = cvt_pk_bf16(v1[2], v1[3]);
                    *(u32x4*)(rowp + bj * HALF) = w; } }
    }
};
struct EpiResF32 {
    static constexpr bool PERM = false;
    const float* R; float* C; int ldc;
    __device__ __forceinline__ void operator()(const f32x4 (&acc)[2][2][4][2], const Unit& u, int wr, int wc, int fr, int fq) const {
        const int row0 = u.pm * BM + wr * 64 + fr, col0 = u.pn * BM + wc * 32 + 4 * fq;
#pragma unroll
        for (int ai = 0; ai < 2; ++ai)
#pragma unroll
            for (int m = 0; m < 4; ++m) { const size_t ro = (size_t)(row0 + ai * HALF + m * 16) * ldc + col0;
#pragma unroll
                for (int bj = 0; bj < 2; ++bj)
#pragma unroll
                    for (int n = 0; n < 2; ++n) { const f32x4 r = *(const f32x4*)(R + ro + bj * HALF + n * 16); *(f32x4*)(C + ro + bj * HALF + n * 16) = acc[ai][bj][m][n] + r; } }
    }
};

template <bool RES_BF16> struct EpiResBf16SS {
    static constexpr bool PERM = true;
    const void* R; bf16_t* O; float* ssp; int ldc;
    __device__ __forceinline__ void operator()(const f32x4 (&acc)[2][2][4][2], const Unit& u, int wr, int wc, int fr, int fq) const {
        const int row0 = u.pm * BM + wr * 64 + fr; const int col0 = u.pn * BM + wc * 32 + 8 * fq;
        constexpr int MB = 4;
#pragma unroll
        for (int ai = 0; ai < 2; ++ai)
#pragma unroll
            for (int m0 = 0; m0 < 4; m0 += MB) {
                f32x4 rf[MB][2][2]; u32x4 rb[MB][2];
#pragma unroll
                for (int mm = 0; mm < MB; ++mm) { const size_t ro = (size_t)(row0 + ai * HALF + (m0 + mm) * 16) * ldc + col0;
#pragma unroll
                    for (int bj = 0; bj < 2; ++bj) {
                        if (RES_BF16) rb[mm][bj] = *(const u32x4*)((const bf16_t*)R + ro + bj * HALF);
                        else { rf[mm][bj][0] = *(const f32x4*)((const float*)R + ro + bj * HALF); rf[mm][bj][1] = *(const f32x4*)((const float*)R + ro + bj * HALF + 4); } } }
#pragma unroll
                for (int mm = 0; mm < MB; ++mm) { const int m = m0 + mm; const int row = row0 + ai * HALF + m * 16; const size_t ro = (size_t)row * ldc + col0; float ss = 0.f;
#pragma unroll
                    for (int bj = 0; bj < 2; ++bj) { f32x4 v0 = acc[ai][bj][m][0], v1 = acc[ai][bj][m][1];
                        if (RES_BF16) { const u32x4 r = rb[mm][bj];
                            v0[0] += __uint_as_float(r.x << 16); v0[1] += __uint_as_float(r.x & 0xffff0000u); v0[2] += __uint_as_float(r.y << 16); v0[3] += __uint_as_float(r.y & 0xffff0000u);
                            v1[0] += __uint_as_float(r.z << 16); v1[1] += __uint_as_float(r.z & 0xffff0000u); v1[2] += __uint_as_float(r.w << 16); v1[3] += __uint_as_float(r.w & 0xffff0000u); }
                        else { v0 += rf[mm][bj][0]; v1 += rf[mm][bj][1]; }
#pragma unroll
                        for (int j = 0; j < 4; ++j) ss += v0[j] * v0[j] + v1[j] * v1[j];
                        u32x4 w; w.x = cvt_pk_bf16(v0[0], v0[1]); w.y = cvt_pk_bf16(v0[2], v0[3]); w.z = cvt_pk_bf16(v1[0], v1[1]); w.w = cvt_pk_bf16(v1[2], v1[3]);
                        *(u32x4*)(O + ro + bj * HALF) = w; }
                    ss += __shfl_xor(ss, 16, 64); ss += __shfl_xor(ss, 32, 64);
                    if (fq == 0) ssp[(size_t)row * 16 + u.pn * 4 + wc] = ss; }
            }
    }
};
struct EpiScaleRelu2 {
    static constexpr bool PERM = true;
    bf16_t* O; const float* ssp; int ldc; const LDSQ float* rsl; int pmA, pmB;
    __device__ __forceinline__ void operator()(const f32x4 (&acc)[2][2][4][2], const Unit& u, int wr, int wc, int fr, int fq) const {
        const int row0 = u.pm * BM + wr * 64 + fr; const int col0 = u.pn * BM + wc * 32 + 8 * fq;
        float rs[2][4];
        if (u.pm == pmA || u.pm == pmB) { const LDSQ float* r = rsl + (u.pm == pmA ? 0 : 256) + wr * 64 + fr;
#pragma unroll
            for (int ai = 0; ai < 2; ++ai)
#pragma unroll
                for (int m = 0; m < 4; ++m) rs[ai][m] = r[ai * HALF + m * 16]; }
        else {
#pragma unroll
            for (int ai = 0; ai < 2; ++ai)
#pragma unroll
                for (int m = 0; m < 4; ++m) { const f32x4* sp = (const f32x4*)(ssp + (size_t)(row0 + ai * HALF + m * 16) * 16); const f32x4 s4 = (sp[0] + sp[1]) + (sp[2] + sp[3]);
                    rs[ai][m] = rsqrtf((s4[0] + s4[1] + s4[2] + s4[3]) * (1.0f / 1024.0f) + 1e-5f); } }
#pragma unroll
        for (int ai = 0; ai < 2; ++ai)
#pragma unroll
            for (int m = 0; m < 4; ++m) { const int row = row0 + ai * HALF + m * 16; bf16_t* rowp = O + (size_t)row * ldc + col0; const float s = rs[ai][m];
#pragma unroll
                for (int bj = 0; bj < 2; ++bj) { f32x4 v0 = acc[ai][bj][m][0], v1 = acc[ai][bj][m][1];
#pragma unroll
                    for (int j = 0; j < 4; ++j) { const float a = fmaxf(v0[j] * s, 0.f), b = fmaxf(v1[j] * s, 0.f); v0[j] = a * a; v1[j] = b * b; }
                    u32x4 w; w.x = cvt_pk_bf16(v0[0], v0[1]); w.y = cvt_pk_bf16(v0[2], v0[3]); w.z = cvt_pk_bf16(v1[0], v1[1]); w.w = cvt_pk_bf16(v1[2], v1[3]);
                    *(u32x4*)(rowp + bj * HALF) = w; } }
    }
};

template <class Epi, class Sched>
__device__ __forceinline__ void gemm_phase(LDSQ unsigned char* lds, const Gemm g, const Sched& S, const Epi& E) {
    const int tid = opaque_tid(), wid = __builtin_amdgcn_readfirstlane(tid >> 6), lane = tid & 63, wr = wid >> 2, wc = wid & 3, fr = lane & 15, fq = lane >> 4;
    const int K = g.K, nt = K / BK;
    unsigned voffA[2], voffB[2];
#pragma unroll
    for (int i = 0; i < 2; ++i) { int R, C; stage_rc(tid * 16 + i * 8192, R, C); const int Rb = Epi::PERM ? ((R & ~31) + perm32(R & 31)) : R;
        voffA[i] = (unsigned)(R * K + C) * 2u; voffB[i] = (unsigned)(Rb * K + C) * 2u; }
    const size_t kstep = (size_t)(BK * 2);
    const size_t hstep = (size_t)HALF * K * 2;
    const size_t tstep = 2 * hstep;
    const unsigned ldsw = (unsigned)wid * 1024u;
    const int aoff = lds_byte(wr * 64 + fr, fq * 8), boff = lds_byte(wc * 32 + fr, fq * 8);
#define PG8_SA(b, h) (((b) * 2 + (h)) * HTB)
#define PG8_SB(b, h) ((4 + (b) * 2 + (h)) * HTB)
#define PG8_STAGE(bufoff, gbase, voff) do { _Pragma("unroll") for (int _i = 0; _i < 2; ++_i) \
        __builtin_amdgcn_global_load_lds((const unsigned*)((const char*)(gbase) + (voff)[_i]), (LDSQ unsigned*)(lds + (bufoff) + ldsw + _i * 8192), 16, 0, 0); } while (0)
#define PG8_LDA(dst, b, h) do { _Pragma("unroll") for (int m = 0; m < 4; ++m) _Pragma("unroll") for (int k = 0; k < 2; ++k) dst[m][k] = *(const LDSQ bf16x8*)(lds + PG8_SA(b, h) + aoff + m * 2048 + k * 1024); } while (0)
#define PG8_LDB(dst, b, h) do { _Pragma("unroll") for (int n = 0; n < 2; ++n) _Pragma("unroll") for (int k = 0; k < 2; ++k) dst[n][k] = *(const LDSQ bf16x8*)(lds + PG8_SB(b, h) + boff + n * 2048 + k * 1024); } while (0)
#define PG8_MMA(ai, bj, At, Bt) do { __builtin_amdgcn_s_setprio(1); _Pragma("unroll") for (int m = 0; m < 4; ++m) _Pragma("unroll") for (int n = 0; n < 2; ++n) _Pragma("unroll") for (int k = 0; k < 2; ++k) \
        acc[ai][bj][m][n] = __builtin_amdgcn_mfma_f32_16x16x32_bf16(Bt[n][k], At[m][k], acc[ai][bj][m][n], 0, 0, 0); __builtin_amdgcn_s_setprio(0); } while (0)
#define PG8_WAIT_V(n) asm volatile("s_waitcnt vmcnt(" #n ")" ::: "memory")
#define PG8_WAIT_L(n) asm volatile("s_waitcnt lgkmcnt(" #n ")" ::: "memory")
#define PG8_BAR __builtin_amdgcn_s_barrier()
#define PG8_SCHED __builtin_amdgcn_sched_barrier(0)
    Unit cur, nxt; int ui = 0;
    if (!S.next(0, cur)) return;
    f32x4 acc[2][2][4][2];
#pragma unroll
    for (int a = 0; a < 2; ++a)
#pragma unroll
        for (int b = 0; b < 2; ++b)
#pragma unroll
            for (int m = 0; m < 4; ++m)
#pragma unroll
                for (int n = 0; n < 2; ++n) acc[a][b][m][n] = (f32x4){0.f, 0.f, 0.f, 0.f};
    bf16x8 At[4][2], B0[2][2], B1[2][2];
    const char* cA = (const char*)g.A + (size_t)cur.pm * tstep; const char* cB = (const char*)g.Bt + (size_t)cur.pn * tstep;
    S.a_ready(cur);
    PG8_STAGE(PG8_SB(0, 0), cB, voffB); PG8_STAGE(PG8_SA(0, 0), cA, voffA); PG8_STAGE(PG8_SB(0, 1), cB + hstep, voffB); PG8_STAGE(PG8_SA(0, 1), cA + hstep, voffA);
    if (wr == 1) PG8_BAR;
    PG8_WAIT_V(4); PG8_BAR;
    PG8_STAGE(PG8_SB(1, 0), cB + kstep, voffB); PG8_STAGE(PG8_SA(1, 0), cA + kstep, voffA); PG8_STAGE(PG8_SB(1, 1), cB + hstep + kstep, voffB);
    PG8_WAIT_V(6); PG8_BAR;
    for (;;) {
        const bool has_next = S.next(ui + 1, nxt);
        const char* nA = has_next ? (const char*)g.A + (size_t)nxt.pm * tstep : cA; const char* nB = has_next ? (const char*)g.Bt + (size_t)nxt.pn * tstep : cB;
        for (int t = 0; t < nt; t += 2) {
            const bool last = (t == nt - 2);
            const char* a1 = cA + (size_t)(t + 1) * kstep;
            const char* a2 = last ? nA : cA + (size_t)(t + 2) * kstep; const char* b2 = last ? nB : cB + (size_t)(t + 2) * kstep;
            const char* a3 = a2 + kstep; const char* b3 = b2 + kstep;
            if (last && has_next) S.a_ready(nxt);
            PG8_LDB(B0, 0, 0); PG8_SCHED; PG8_LDA(At, 0, 0); PG8_STAGE(PG8_SA(1, 1), a1 + hstep, voffA);
            PG8_WAIT_L(8); PG8_BAR; PG8_WAIT_L(0); PG8_MMA(0, 0, At, B0); PG8_BAR; PG8_SCHED;
            PG8_LDB(B1, 0, 1); PG8_STAGE(PG8_SB(0, 0), b2, voffB);
            PG8_BAR; PG8_WAIT_L(0); PG8_MMA(0, 1, At, B1); PG8_BAR;
            PG8_LDA(At, 0, 1); PG8_STAGE(PG8_SA(0, 0), a2, voffA);
            PG8_BAR; PG8_WAIT_L(0); PG8_MMA(1, 0, At, B0); PG8_BAR; PG8_SCHED;
            PG8_STAGE(PG8_SB(0, 1), b2 + hstep, voffB);
            PG8_WAIT_V(6); PG8_BAR; PG8_MMA(1, 1, At, B1); PG8_BAR;
            PG8_LDB(B0, 1, 0); PG8_SCHED; PG8_LDA(At, 1, 0); PG8_STAGE(PG8_SA(0, 1), a2 + hstep, voffA);
            PG8_WAIT_L(8); PG8_BAR; PG8_WAIT_L(0); PG8_MMA(0, 0, At, B0); PG8_BAR; PG8_SCHED;
            PG8_LDB(B1, 1, 1); PG8_STAGE(PG8_SB(1, 0), b3, voffB);
            PG8_BAR; PG8_WAIT_L(0); PG8_MMA(0, 1, At, B1); PG8_BAR;
            PG8_LDA(At, 1, 1); PG8_STAGE(PG8_SA(1, 0), a3, voffA);
            PG8_BAR; PG8_WAIT_L(0); PG8_MMA(1, 0, At, B0); PG8_BAR; PG8_SCHED;
            PG8_STAGE(PG8_SB(1, 1), b3 + hstep, voffB);
            PG8_WAIT_V(6); PG8_BAR; PG8_MMA(1, 1, At, B1); PG8_BAR;
        }
        E(acc, cur, wr, wc, fr, fq); S.done(cur);
        if (!has_next) break;
#pragma unroll
        for (int a = 0; a < 2; ++a)
#pragma unroll
            for (int b = 0; b < 2; ++b)
#pragma unroll
                for (int m = 0; m < 4; ++m)
#pragma unroll
                    for (int n = 0; n < 2; ++n) acc[a][b][m][n] = (f32x4){0.f, 0.f, 0.f, 0.f};
        cur = nxt; cA = nA; cB = nB; ++ui;
    }
    PG8_WAIT_V(0);
    if (wr == 0) PG8_BAR;
    PG8_BAR;
#undef PG8_SA
#undef PG8_SB
#undef PG8_STAGE
#undef PG8_LDA
#undef PG8_LDB
#undef PG8_MMA
#undef PG8_WAIT_V
#undef PG8_WAIT_L
#undef PG8_BAR
#undef PG8_SCHED
}
}

typedef float f2 __attribute__((ext_vector_type(2)));
#define HD __host__ __device__ __forceinline__

HD f2 cmul(f2 a, f2 b) { const f2 t = (f2){a.x, a.x} * b; return (f2){a.y, a.y} * (f2){-b.y, b.x} + t; }
HD f2 cmulc(f2 a, f2 b) { const f2 t = (f2){a.x, a.x} * (f2){b.x, -b.y}; return (f2){a.y, a.y} * (f2){b.y, b.x} + t; }
HD f2 cconj(f2 a) { return (f2){a.x, -a.y}; }
HD f2 twid(float x) {
#ifdef __HIP_DEVICE_COMPILE__
    return (f2){cospif(x), -sinpif(x)};
#else
    return (f2){(float)cos(3.14159265358979323846 * (double)x), (float)-sin(3.14159265358979323846 * (double)x)};
#endif
}
HD constexpr int rev16(int i) { return (i >> 2) | ((i & 3) << 2); }

template <bool INV> HD void bfly4(f2& x0, f2& x1, f2& x2, f2& x3) {
    const f2 t0 = x0 + x2, t1 = x0 - x2, t2 = x1 + x3, t3 = x1 - x3;
    const f2 it3 = INV ? (f2){-t3.y, t3.x} : (f2){t3.y, -t3.x};
    x0 = t0 + t2; x1 = t1 + it3; x2 = t0 - t2; x3 = t1 - it3;
}
template <bool INV> HD f2 mulw(f2 z, float c, float s) {
    const float ss = INV ? s : -s;
    const f2 zr = (f2){-z.y, z.x};
    return z * c + zr * ss;
}
template <bool INV> HD void fft16(f2 (&v)[16]) {
#pragma unroll
    for (int j = 0; j < 4; ++j) bfly4<INV>(v[j], v[j + 4], v[j + 8], v[j + 12]);
    const float C1 = 0.92387953251128674f, S1 = 0.38268343236508977f, H = 0.70710678118654752f;
    v[5] = mulw<INV>(v[5], C1, S1);  v[9] = mulw<INV>(v[9], H, H);     v[13] = mulw<INV>(v[13], S1, C1);
    v[6] = mulw<INV>(v[6], H, H);    v[10] = mulw<INV>(v[10], 0.f, 1.f); v[14] = mulw<INV>(v[14], -H, H);
    v[7] = mulw<INV>(v[7], S1, C1);  v[11] = mulw<INV>(v[11], -H, H);  v[15] = mulw<INV>(v[15], -C1, -S1);
#pragma unroll
    for (int q = 0; q < 4; ++q) bfly4<INV>(v[4 * q], v[4 * q + 1], v[4 * q + 2], v[4 * q + 3]);
}
HD int opq(int t) {
#ifdef __HIP_DEVICE_COMPILE__
    asm volatile("" : "+v"(t));
#endif
    return t;
}
HD f2 opq2(f2 w) {
#ifdef __HIP_DEVICE_COMPILE__
    asm volatile("" : "+v"(w.x), "+v"(w.y));
#endif
    return w;
}
HD void tw_table(f2 base, f2 w1, f2 (&p)[16]) {
    w1 = opq2(w1); base = opq2(base);
    const f2 q2 = cmul(w1, w1), q4 = cmul(q2, q2), q8 = cmul(q4, q4);
    p[0] = base; p[1] = cmul(base, w1); p[2] = cmul(p[0], q2); p[3] = cmul(p[1], q2);
#pragma unroll
    for (int e = 0; e < 4; ++e) p[4 + e] = cmul(p[e], q4);
#pragma unroll
    for (int e = 0; e < 8; ++e) p[8 + e] = cmul(p[e], q8);
}
template <int STRIDE> HD void apply_store(const f2 (&v)[16], const f2 (&p)[16], LDSQ f2* a) {
#pragma unroll
    for (int e = 0; e < 16; ++e) a[STRIDE * e] = cmul(v[rev16(e)], p[e]);
}
template <int STRIDE> HD void apply_store_conj(const f2 (&v)[16], const f2 (&p)[16], LDSQ f2* a) {
#pragma unroll
    for (int e = 0; e < 16; ++e) a[STRIDE * e] = cmulc(v[rev16(e)], p[e]);
}
template <int STRIDE, bool INV> HD void read_fft(LDSQ f2* a, f2 (&v)[16]) {
#pragma unroll
    for (int i = 0; i < 16; ++i) v[i] = a[STRIDE * i];
    fft16<INV>(v);
}
HD LDSQ f2* base_p1(LDSQ f2* arr, int t) { t = opq(t) & 255; return arr + (t + (t >> 4)); }
HD LDSQ f2* base_p2(LDSQ f2* arr, int t) { t = opq(t) & 255; return arr + (272 * (t >> 4) + (t & 15)); }
HD LDSQ f2* base_p3(LDSQ f2* arr, int t) { t = opq(t) & 255; return arr + 17 * t; }

struct FftTw { f2 w_p1, w_p2, b_i2, w_i2; };
HD FftTw make_tw(int t) {
    const int k0 = t >> 4, n0 = t & 15;
    FftTw w;
    w.w_p1 = twid((float)t * (1.0f / 2048.0f));
    w.w_p2 = twid((float)n0 * (1.0f / 128.0f));
    w.b_i2 = cconj(twid((float)(n0 * k0) * (1.0f / 2048.0f)));
    w.w_i2 = cconj(twid((float)k0 * (1.0f / 128.0f)));
    return w;
}

__device__ __forceinline__ float bf2f(bf16_t b) { return __uint_as_float(((unsigned)b) << 16); }
__device__ __forceinline__ bf16_t f2bf(float f) { unsigned u = __float_as_uint(f); u += 0x7FFFu + ((u >> 16) & 1u); return (bf16_t)(u >> 16); }
__device__ __forceinline__ unsigned pack2(float lo, float hi) { return (unsigned)f2bf(lo) | ((unsigned)f2bf(hi) << 16); }
__device__ __forceinline__ float wave_sum(float v) {
#pragma unroll
    for (int o = 32; o > 0; o >>= 1) v += __shfl_xor(v, o, 64);
    return v;
}
__device__ __forceinline__ float sin_acc(float x) { return sinpif(x * 0.31830988618379067f); }

struct Params {
    const float* in[19];
    float* out;
    unsigned char* ws;
    int ph_lo, ph_hi;
};

__device__ __forceinline__ void transpose_w(const float* __restrict__ src, int K, int N, bf16_t* __restrict__ dst, int premix_cols, const float* __restrict__ kscale, LDSQ float* tile, LDSQ float* cs) {
    const int tid = opaque_tid(), ntk = K / 64, ntn = N / 64, ntl = ntk * ntn;
    const int r0 = tid >> 4, c4 = tid & 15;
    f32x4 nx0, nx1;
    int tl = blockIdx.x;
    if (tl < ntl) { const int k0 = (tl % ntk) * 64, n0 = (tl / ntk) * 64;
        nx0 = *(const f32x4*)(src + (size_t)(k0 + r0) * N + n0 + c4 * 4); nx1 = *(const f32x4*)(src + (size_t)(k0 + r0 + 32) * N + n0 + c4 * 4); }
    for (; tl < ntl; tl += gridDim.x) {
        const int kt = tl % ntk, nt = tl / ntk, k0 = kt * 64, n0 = nt * 64;
        __syncthreads();
        tile[r0 * 65 + c4 * 4 + 0] = nx0[0]; tile[r0 * 65 + c4 * 4 + 1] = nx0[1]; tile[r0 * 65 + c4 * 4 + 2] = nx0[2]; tile[r0 * 65 + c4 * 4 + 3] = nx0[3];
        tile[(r0 + 32) * 65 + c4 * 4 + 0] = nx1[0]; tile[(r0 + 32) * 65 + c4 * 4 + 1] = nx1[1]; tile[(r0 + 32) * 65 + c4 * 4 + 2] = nx1[2]; tile[(r0 + 32) * 65 + c4 * 4 + 3] = nx1[3];
        __syncthreads();
        { const int tn = tl + gridDim.x;
          if (tn < ntl) { const int k1 = (tn % ntk) * 64, n1 = (tn / ntk) * 64;
            nx0 = *(const f32x4*)(src + (size_t)(k1 + r0) * N + n1 + c4 * 4); nx1 = *(const f32x4*)(src + (size_t)(k1 + r0 + 32) * N + n1 + c4 * 4); } }
        const int n = tid >> 3, kc = tid & 7;
        float o[8];
        if (n0 < premix_cols) {
#pragma unroll
            for (int e = 0; e < 8; ++e) o[e] = 0.f;
#pragma unroll 2
            for (int c = 0; c < 64; ++c) {
                const float mcoef = (n <= 32) ? cs[(c * n) & 63] : -cs[64 + ((c * (n - 32)) & 63)];
#pragma unroll
                for (int e = 0; e < 8; ++e) o[e] += tile[(kc * 8 + e) * 65 + c] * mcoef;
            }
#pragma unroll
            for (int e = 0; e < 8; ++e) o[e] *= (1.0f / 512.0f);
        } else {
#pragma unroll
            for (int e = 0; e < 8; ++e) o[e] = tile[(kc * 8 + e) * 65 + n];
        }
        if (kscale) {
#pragma unroll
            for (int e = 0; e < 8; ++e) o[e] *= kscale[k0 + kc * 8 + e]; }
        u32x4 w; w.x = pack2(o[0], o[1]); w.y = pack2(o[2], o[3]); w.z = pack2(o[4], o[5]); w.w = pack2(o[6], o[7]);
        *(u32x4*)(dst + (size_t)(n0 + n) * K + k0 + kc * 8) = w;
    }
}

template <bool OUT_BF16>
__device__ __forceinline__ void rmsnorm_rows(const float* X, const float* __restrict__ g, void* outp, int rows) {
    const int tid0 = opaque_tid(), lane = tid0 & 63, wid = tid0 >> 6;
    for (int row = (blockIdx.x * 8 + wid) * 4; row < rows; row += gridDim.x * 32) {
        f32x4 v[4][4]; float ss[4] = {0.f, 0.f, 0.f, 0.f};
#pragma unroll
        for (int q = 0; q < 4; ++q) { const f32x4* xr = (const f32x4*)(X + (size_t)(row + q) * DM);
#pragma unroll
            for (int i = 0; i < 4; ++i) v[q][i] = __builtin_nontemporal_load(xr + lane + 64 * i); }
#pragma unroll
        for (int q = 0; q < 4; ++q) {
#pragma unroll
            for (int i = 0; i < 4; ++i) ss[q] += v[q][i][0] * v[q][i][0] + v[q][i][1] * v[q][i][1] + v[q][i][2] * v[q][i][2] + v[q][i][3] * v[q][i][3];
            ss[q] = wave_sum(ss[q]); }
#pragma unroll
        for (int q = 0; q < 4; ++q) { const float rs = rsqrtf(ss[q] * (1.0f / DM) + EPSF);
#pragma unroll
            for (int i = 0; i < 4; ++i) { const f32x4 gg = ((const f32x4*)g)[lane + 64 * i]; const f32x4 o = v[q][i] * rs * gg;
                if (OUT_BF16) { u32x2 w; w.x = pack2(o[0], o[1]); w.y = pack2(o[2], o[3]); *(u32x2*)((bf16_t*)outp + (size_t)(row + q) * DM + (lane + 64 * i) * 4) = w; }
                else *(f32x4*)((float*)outp + (size_t)(row + q) * DM + (lane + 64 * i) * 4) = o; } }
    }
}

__device__ __forceinline__ void final_norm(const bf16_t* __restrict__ X, const float* __restrict__ ssp, const float* __restrict__ g, float* __restrict__ out) {
    const int tid0 = opaque_tid(), lane = tid0 & 63, wid = tid0 >> 6;
    f32x4 g0[2], g1[2];
#pragma unroll
    for (int i = 0; i < 2; ++i) { const int c0 = (lane + 64 * i) * 8; g0[i] = *(const f32x4*)(g + c0); g1[i] = *(const f32x4*)(g + c0 + 4); }
    for (int row = (blockIdx.x * 8 + wid) * 4; row < NTOK; row += gridDim.x * 32) {
        u32x4 r[4][2]; f32x4 s4[4];
#pragma unroll
        for (int q = 0; q < 4; ++q) { const f32x4* sp = (const f32x4*)(ssp + (size_t)(row + q) * 16); s4[q] = (sp[0] + sp[1]) + (sp[2] + sp[3]);
#pragma unroll
            for (int i = 0; i < 2; ++i) r[q][i] = *(const u32x4*)(X + (size_t)(row + q) * DM + (lane + 64 * i) * 8); }
#pragma unroll
        for (int q = 0; q < 4; ++q) { const float rs = rsqrtf((s4[q][0] + s4[q][1] + s4[q][2] + s4[q][3]) * (1.0f / DM) + EPSF);
#pragma unroll
            for (int i = 0; i < 2; ++i) { const int c0 = (lane + 64 * i) * 8; const u32x4 rr = r[q][i];
                f32x4 o0, o1;
                o0[0] = __uint_as_float(rr.x << 16); o0[1] = __uint_as_float(rr.x & 0xffff0000u); o0[2] = __uint_as_float(rr.y << 16); o0[3] = __uint_as_float(rr.y & 0xffff0000u);
                o1[0] = __uint_as_float(rr.z << 16); o1[1] = __uint_as_float(rr.z & 0xffff0000u); o1[2] = __uint_as_float(rr.w << 16); o1[3] = __uint_as_float(rr.w & 0xffff0000u);
                *(f32x4*)(out + (size_t)(row + q) * DM + c0) = o0 * rs * g0[i]; *(f32x4*)(out + (size_t)(row + q) * DM + c0 + 4) = o1 * rs * g1[i]; } }
    }
}

__device__ __forceinline__ void filter_mlp(const Params& P, float* __restrict__ hfilt, LDSQ float* lds) {
    const float* wout = P.in[10];
    LDSQ float* zf = lds; LDSQ float* ha = lds + 544; LDSQ float* hb = ha + 1024; LDSQ float* hT = hb + 1024;
    LDSQ float* w0s = hT + 1024; LDSQ float* wis = w0s + 2112; LDSQ float* b0s = wis + 8192; LDSQ float* bis = b0s + 64; LDSQ float* frs = bis + 128;
    const int tid = opaque_tid();
    __syncthreads();
    for (int i = tid; i < 2112; i += 512) w0s[i] = P.in[5][i];
    for (int i = tid; i < 8192; i += 512) wis[i] = P.in[7][i];
    if (tid < 64) { b0s[tid] = P.in[6][tid]; frs[tid] = P.in[9][tid]; }
    if (tid < 128) bis[tid] = P.in[8][tid];
    for (int blk = blockIdx.x; blk < SEQ / 16; blk += gridDim.x) {
        const int l0 = blk * 16;
        __syncthreads();
        for (int idx = tid; idx < 16 * 33; idx += 512) {
            const int l = idx / 33, f = idx - l * 33, pos = l0 + l; float val;
            if (f == 0) val = (float)pos / 4095.0f;
            else { const int j = (f - 1) & 15; const float band = 1e-4f + (float)j * ((15.0f - 1e-4f) / 15.0f); const float x = ((float)pos * (1.0f / 2048.0f)) * band;
                val = (f <= 16) ? cospif(x) : -sinpif(x); }
            zf[idx] = val;
        }
        __syncthreads();
#pragma unroll
        for (int r = 0; r < 2; ++r) { const int idx = tid + 512 * r, l = idx >> 6, u = idx & 63; float s = b0s[u];
#pragma unroll 11
            for (int f = 0; f < 33; ++f) s += zf[l * 33 + f] * w0s[f * 64 + u];
            ha[idx] = sin_acc(frs[u] * s); }
        __syncthreads();
#pragma unroll
        for (int r = 0; r < 2; ++r) { const int idx = tid + 512 * r, l = idx >> 6, u = idx & 63; float s = bis[u];
#pragma unroll 16
            for (int i = 0; i < 64; ++i) s += ha[l * 64 + i] * wis[i * 64 + u];
            hb[idx] = sin_acc(frs[u] * s); }
        __syncthreads();
#pragma unroll
        for (int r = 0; r < 2; ++r) { const int idx = tid + 512 * r, l = idx >> 6, u = idx & 63; float s = bis[64 + u];
#pragma unroll 16
            for (int i = 0; i < 64; ++i) s += hb[l * 64 + i] * wis[4096 + i * 64 + u];
            hT[u * 16 + l] = sin_acc(frs[u] * s); }
        __syncthreads();
        {
            const int lane = tid & 63, wvi = tid >> 6, li = lane & 15, lk = lane >> 4;
            float av[16];
#pragma unroll
            for (int st = 0; st < 16; ++st) av[st] = hT[(4 * st + lk) * 16 + li];
            const float dmin = -3.0701134573253945f, dmax = -15.350567286626973f;
#pragma unroll 1
            for (int ct0 = 0; ct0 < 16; ct0 += 2) {
                float bv[2][16];
#pragma unroll
                for (int q = 0; q < 2; ++q) { const int col0 = (wvi * 16 + ct0 + q) * 16;
#pragma unroll
                    for (int st = 0; st < 16; ++st) bv[q][st] = wout[(4 * st + lk) * 2048 + col0 + li]; }
#pragma unroll
                for (int q = 0; q < 2; ++q) { const int col = (wvi * 16 + ct0 + q) * 16 + li;
                    f32x4 d = (f32x4){0.f, 0.f, 0.f, 0.f};
#pragma unroll
                    for (int st = 0; st < 16; ++st) d = __builtin_amdgcn_mfma_f32_16x16x4f32(av[st], bv[q][st], d, 0, 0, 0);
                    const float delta = fabsf(dmin + (float)(col & 511) * ((dmax - dmin) / 511.0f));
                    float dec = expf(-((float)(l0 + 4 * lk) / 4095.0f) * delta); const float rstep = expf(-delta / 4095.0f);
                    f32x4 o;
                    o[0] = d[0] * dec; dec *= rstep; o[1] = d[1] * dec; dec *= rstep; o[2] = d[2] * dec; dec *= rstep; o[3] = d[3] * dec;
                    *(f32x4*)(hfilt + (size_t)col * SEQ + l0 + 4 * lk) = o; }
            }
        }
    }
}

struct Raw8 { u32x4 a, b; unsigned la, ra, lb, rb; };
__device__ __forceinline__ void load_raw8(const bf16_t* __restrict__ pa, const bf16_t* __restrict__ pb, int tl, Raw8& r) {
    const int il = tl > 0 ? 8 * tl - 1 : 0, ir = tl < 511 ? 8 * tl + 8 : 8 * tl + 7;
    r.a = *(const u32x4*)(pa + 8 * tl); r.b = *(const u32x4*)(pb + 8 * tl);
    r.la = pa[il]; r.ra = pa[ir]; r.lb = pb[il]; r.rb = pb[ir];
}
__device__ __forceinline__ void sconv8(const u32x4 r, unsigned l, unsigned rr, int tl, float w0, float w1, float w2, float bias, float (&u)[8]) {
    float x[10];
    x[1] = __uint_as_float(r.x << 16); x[2] = __uint_as_float(r.x & 0xffff0000u); x[3] = __uint_as_float(r.y << 16); x[4] = __uint_as_float(r.y & 0xffff0000u);
    x[5] = __uint_as_float(r.z << 16); x[6] = __uint_as_float(r.z & 0xffff0000u); x[7] = __uint_as_float(r.w << 16); x[8] = __uint_as_float(r.w & 0xffff0000u);
    x[0] = tl > 0 ? __uint_as_float(l << 16) : 0.f; x[9] = tl < 511 ? __uint_as_float(rr << 16) : 0.f;
#pragma unroll
    for (int i = 0; i < 8; ++i) u[i] = w0 * x[i] + w1 * x[i + 1] + w2 * x[i + 2] + bias;
}
#define FFT_PIN() __builtin_amdgcn_sched_barrier(0)
template <bool KLDS>
__device__ __forceinline__ void conv4096(LDSQ f2* arr, int t, const FftTw& w, const f2 (&K)[16], const LDSQ f2* Kl  ) {
    f2 p[16], v[16];
    tw_table((f2){1.f, 0.f}, w.w_p1, p);
    __syncthreads();
    { LDSQ f2* a = base_p1(arr, t); read_fft<272, false>(a, v); apply_store<272>(v, p, a); }
    FFT_PIN(); tw_table((f2){1.f, 0.f}, w.w_p2, p); __syncthreads();
    { LDSQ f2* a = base_p2(arr, t); read_fft<17, false>(a, v); apply_store<17>(v, p, a); }
    __syncthreads();
    { LDSQ f2* a = base_p3(arr, t); read_fft<1, false>(a, v);
      f2 u[16];
#pragma unroll
      for (int i = 0; i < 16; ++i) u[rev16(i)] = cmul(v[i], KLDS ? Kl[512 * i] : K[i]);
      fft16<true>(u); apply_store_conj<1>(u, p, a); }
    FFT_PIN(); tw_table(w.b_i2, w.w_i2, p); __syncthreads();
    { LDSQ f2* a = base_p2(arr, t); read_fft<17, true>(a, v); apply_store<17>(v, p, a); }
    __syncthreads();
    { LDSQ f2* a = base_p1(arr, t); read_fft<272, true>(a, v);
#pragma unroll
      for (int i = 0; i < 16; ++i) a[272 * rev16(i)] = v[i]; }
    __syncthreads();
}
struct FRaw { f32x4 f0, f1, r0, r1; float b0; };
__device__ __forceinline__ void load_fraw(const float* __restrict__ hf, const float* __restrict__ hb, int tl, FRaw& r) {
    r.f0 = *(const f32x4*)(hf + 8 * tl); r.f1 = *(const f32x4*)(hf + 8 * tl + 4);
    r.r0 = *(const f32x4*)(hb + 4088 - 8 * tl); r.r1 = *(const f32x4*)(hb + 4092 - 8 * tl);
    r.b0 = hb[(SEQ - 8 * tl) & (SEQ - 1)];
}
__device__ __forceinline__ void filter_spec(FRaw& fr, const float* __restrict__ nhf, const float* __restrict__ nhb, float dskip, LDSQ f2* E, LDSQ f2* O, LDSQ float* red, LDSQ f2* arr, int tid, int t, const FftTw& w, f2 wt, f2 (&K)[16]) {
    const f2 WSTEP = (f2){0.9999997058628822f, -0.0007669903187427045f};
    const int tl = opq(tid) & 511, pe = 8 * tl + (tl >> 1);
    float ss = 0.f; f2 tw = opq2(wt);
    float f[8], bb[8];
    { const f32x4 f0 = fr.f0, f1 = fr.f1, r0 = fr.r0, r1 = fr.r1;
      f[0] = f0[0]; f[1] = f0[1]; f[2] = f0[2]; f[3] = f0[3]; f[4] = f1[0]; f[5] = f1[1]; f[6] = f1[2]; f[7] = f1[3];
      bb[0] = fr.b0;
      bb[1] = r1[3]; bb[2] = r1[2]; bb[3] = r1[1]; bb[4] = r1[0]; bb[5] = r0[3]; bb[6] = r0[2]; bb[7] = r0[1]; }
    if (nhf) load_fraw(nhf, nhb, tl, fr);
#pragma unroll
    for (int i = 0; i < 8; ++i) {
        const float ke = f[i] + bb[i]; float ko = f[i] - bb[i]; ss += f[i] * f[i] + bb[i] * bb[i];
        if (i == 0) { ko = tl == 0 ? ke : ko; ss += tl == 0 ? 2.f * f[0] * bb[0] : 0.f; }
        E[pe + i] = (f2){ke, 0.f}; O[pe + i] = (f2){ko * tw.x, ko * tw.y}; tw = cmul(tw, WSTEP); }
    ss = wave_sum(ss);
    if ((tl & 63) == 0) red[tl >> 6] = ss;
    f2 p[16], v[16];
    tw_table((f2){1.f, 0.f}, w.w_p1, p);
    __syncthreads();
    float tot = 0.f;
#pragma unroll
    for (int q = 0; q < 8; ++q) tot += red[q];
    { LDSQ f2* a = base_p1(arr, t); read_fft<272, false>(a, v); apply_store<272>(v, p, a); }
    FFT_PIN(); tw_table((f2){1.f, 0.f}, w.w_p2, p); __syncthreads();
    { LDSQ f2* a = base_p2(arr, t); read_fft<17, false>(a, v); apply_store<17>(v, p, a); }
    __syncthreads();
    read_fft<1, false>(base_p3(arr, t), v);
    const float scale = rsqrtf(tot + EPSF) * (1.0f / 8192.0f); const float dk = dskip * (1.0f / 8192.0f);
#pragma unroll
    for (int i = 0; i < 16; ++i) K[i] = (f2){v[i].x * scale + dk, v[i].y * scale};
    __syncthreads();
}
__device__ __forceinline__ void fft_phase(const Params& P, LDSQ unsigned char* lds) {
    const bf16_t* __restrict__ pT = (const bf16_t*)(P.ws + WS_PT); bf16_t* __restrict__ yT = (bf16_t*)(P.ws + WS_YT);
    const float* __restrict__ hfilt = (const float*)(P.ws + WS_HF);
    const float* conv_w = P.in[3]; const float* conv_b = P.in[4]; const float* long_d = P.in[11];
    LDSQ f2* E = (LDSQ f2*)lds; LDSQ f2* O = E + 4352; LDSQ float* red = (LDSQ float*)(O + 4352); LDSQ f2* K1l = (LDSQ f2*)(red + 16);
    const int tid = opaque_tid(), team = tid >> 8, t = tid & 255;
    LDSQ f2* arr = team ? O : E;
    const f2 wt = twid((float)tid * (1.0f / 512.0f));
    const FftTw w = make_tw(t);
    const f2 WSTEP = (f2){0.9999997058628822f, -0.0007669903187427045f};
#pragma unroll 1
    for (int c = blockIdx.x; c < 512; c += gridDim.x) {
        const float w1a = conv_w[c], w1b = conv_w[1536 + c], w1c = conv_w[3072 + c], b1 = conv_b[c];
        const float w2a = conv_w[512 + c], w2b = conv_w[1536 + 512 + c], w2c = conv_w[3072 + 512 + c], b2 = conv_b[512 + c];
        const float wva = conv_w[1024 + c], wvb = conv_w[1536 + 1024 + c], wvc = conv_w[3072 + 1024 + c], bv = conv_b[1024 + c];
        f2 K0[16];
        const bf16_t* px1 = pT + (size_t)(512 + c) * NTOK; const bf16_t* px2 = pT + (size_t)(1024 + c) * NTOK; const bf16_t* pv = pT + (size_t)(1536 + c) * NTOK;
        bf16_t* yo = yT + (size_t)(512 + c) * NTOK;
        FRaw fr; load_fraw(hfilt + (size_t)(2 * 512 + c) * SEQ, hfilt + (size_t)(3 * 512 + c) * SEQ, opq(tid) & 511, fr);
        filter_spec(fr, hfilt + (size_t)(0 * 512 + c) * SEQ, hfilt + (size_t)(1 * 512 + c) * SEQ, long_d[512 + c], E, O, red, arr, tid, t, w, wt, K0);
        { LDSQ f2* kl = K1l + (opq(tid) & 511);
#pragma unroll
          for (int i = 0; i < 16; ++i) kl[512 * i] = K0[i]; }
        Raw8 raw;
        load_raw8(pv, pv + SEQ, opq(tid) & 511, raw);
        filter_spec(fr, nullptr, nullptr, long_d[c], E, O, red, arr, tid, t, w, wt, K0);
#pragma unroll 1
        for (int pr = 0; pr < 4; ++pr) {
            const int o1 = (2 * pr) * SEQ, o2 = (2 * pr + 1) * SEQ;
            { const int tl = opq(tid) & 511, pe = 8 * tl + (tl >> 1); f2 tw = opq2(wt);
              float ua[8], ub[8]; sconv8(raw.a, raw.la, raw.ra, tl, wva, wvb, wvc, bv, ua); sconv8(raw.b, raw.lb, raw.rb, tl, wva, wvb, wvc, bv, ub);
              load_raw8(px1 + o1, px1 + o2, tl, raw);
#pragma unroll
              for (int i = 0; i < 8; ++i) { const f2 z = (f2){ua[i], ub[i]};
                E[pe + i] = z; O[pe + i] = cmul(z, tw); tw = cmul(tw, WSTEP); } }
            conv4096<false>(arr, t, w, K0, nullptr);
            { const int tl = opq(tid) & 511, pe = 8 * tl + (tl >> 1); f2 tw = opq2(wt);
              float ua[8], ub[8]; sconv8(raw.a, raw.la, raw.ra, tl, w1a, w1b, w1c, b1, ua); sconv8(raw.b, raw.lb, raw.rb, tl, w1a, w1b, w1c, b1, ub);
              load_raw8(px2 + o1, px2 + o2, tl, raw);
#pragma unroll
              for (int i = 0; i < 8; ++i) {
                const f2 y = E[pe + i] + cmulc(O[pe + i], tw);
                const f2 z = (f2){ua[i], ub[i]} * y;
                E[pe + i] = z; O[pe + i] = cmul(z, tw); tw = cmul(tw, WSTEP); } }
            conv4096<true>(arr, t, w, K0, K1l + (opq(tid) & 511));
            { const int tl = opq(tid) & 511, pe = 8 * tl + (tl >> 1); f2 tw = opq2(wt);
              float ua[8], ub[8]; sconv8(raw.a, raw.la, raw.ra, tl, w2a, w2b, w2c, b2, ua); sconv8(raw.b, raw.lb, raw.rb, tl, w2a, w2b, w2c, b2, ub);
              { const int on = pr < 3 ? o2 + SEQ : 0; load_raw8(pv + on, pv + on + SEQ, tl, raw); }
              float za[8], zb[8];
#pragma unroll
              for (int i = 0; i < 8; ++i) {
                const f2 y = E[pe + i] + cmulc(O[pe + i], tw);
                za[i] = ua[i] * y.x; zb[i] = ub[i] * y.y; tw = cmul(tw, WSTEP); }
              u32x4 wa, wb;
              wa.x = pack2(za[0], za[1]); wa.y = pack2(za[2], za[3]); wa.z = pack2(za[4], za[5]); wa.w = pack2(za[6], za[7]);
              wb.x = pack2(zb[0], zb[1]); wb.y = pack2(zb[2], zb[3]); wb.z = pack2(zb[4], zb[5]); wb.w = pack2(zb[6], zb[7]);
              *(u32x4*)(yo + o1 + 8 * tl) = wa; *(u32x4*)(yo + o2 + 8 * tl) = wb; }
        }
    }
    __syncthreads();
    unsigned nre[16], nim[16];
    { const int J = blockIdx.x * 2 + team, b = J >> 8, g = (J >> 5) & 7, mm = J & 31, tq = opq(t) & 255;
      const bf16_t* pre = pT + (size_t)(g * 64 + mm) * NTOK + b * SEQ; const bf16_t* pim = pT + (size_t)(g * 64 + 32 + mm) * NTOK + b * SEQ;
#pragma unroll
      for (int i = 0; i < 16; ++i) { nre[i] = pre[256 * i + tq]; nim[i] = pim[256 * i + tq]; } }
#pragma unroll 1
    for (int J0 = blockIdx.x * 2; J0 < 2048; J0 += gridDim.x * 2) {
        const int J = J0 + team, b = J >> 8, g = (J >> 5) & 7, mm = J & 31;
        f2 v[16];
#pragma unroll
        for (int i = 0; i < 16; ++i) v[i] = (f2){__uint_as_float(nre[i] << 16), __uint_as_float(nim[i] << 16)};
        { const int Jn = (J0 + (int)gridDim.x * 2 < 2048 ? J0 + (int)gridDim.x * 2 : J0) + team, bn = Jn >> 8, gn = (Jn >> 5) & 7, mn = Jn & 31, tq = opq(t) & 255;
          const bf16_t* pre = pT + (size_t)(gn * 64 + mn) * NTOK + bn * SEQ; const bf16_t* pim = pT + (size_t)(gn * 64 + 32 + mn) * NTOK + bn * SEQ;
#pragma unroll
          for (int i = 0; i < 16; ++i) { nre[i] = pre[256 * i + tq]; nim[i] = pim[256 * i + tq]; } }
        f2 p[16];
        tw_table((f2){1.f, 0.f}, w.w_p1, p);
        fft16<false>(v); apply_store<272>(v, p, base_p1(arr, t));
        FFT_PIN(); tw_table((f2){1.f, 0.f}, w.w_p2, p); __syncthreads();
        { LDSQ f2* a = base_p2(arr, t); read_fft<17, false>(a, v); apply_store<17>(v, p, a); }
        __syncthreads();
        read_fft<1, false>(base_p3(arr, t), v); __syncthreads();
        { const int tq = opq(t) & 255; LDSQ f2* a = arr + ((tq >> 4) + 17 * (tq & 15));
#pragma unroll
          for (int i = 0; i < 16; ++i) a[272 * rev16(i)] = v[i]; }
        __syncthreads();
        bf16_t* q1 = yT + (size_t)(g * 64 + mm) * NTOK + b * SEQ; bf16_t* q2 = yT + (size_t)(g * 64 + (mm ? 64 - mm : 32)) * NTOK + b * SEQ;
        { const int tq = opq(t) & 255, tr = 256 - tq;
          LDSQ f2* af = arr + (tq + (tq >> 4)); LDSQ f2* ar = arr + (tr + (tr >> 4));
#pragma unroll
          for (int j = 0; j < 16; ++j) { const int k = tq + 256 * j;
            const f2 a = af[272 * j]; f2 r = ar[272 * (15 - j)];
            if (j == 0) r = tq == 0 ? a : r;
            if (mm) { q1[k] = f2bf(a.x); q2[k] = f2bf(r.x); } else { q1[k] = f2bf(0.5f * (a.x + r.x)); q2[k] = f2bf(0.5f * (a.y + r.y)); } } }
        __syncthreads();
    }
}

__device__ __forceinline__ void transpose_norm(const Params& P, LDSQ unsigned char* lds) {
    const bf16_t* __restrict__ yT = (const bf16_t*)(P.ws + WS_YT); bf16_t* __restrict__ y = (bf16_t*)(P.ws + WS_Y);
    const float* gf = P.in[12]; const float* gh = P.in[13];
    const int tid = opaque_tid(), lane = tid & 63, wid = tid >> 6;
    for (int tl = blockIdx.x; tl < NTOK / 64; tl += gridDim.x) {
        const int tok0 = tl * 64;
        __syncthreads();
        u32x4 tv[16];
#pragma unroll
        for (int i = 0; i < 16; ++i) { const int q = tid + 512 * i, ch = q >> 3, part = q & 7; tv[i] = *(const u32x4*)(yT + (size_t)ch * NTOK + tok0 + part * 8); }
#pragma unroll
        for (int i = 0; i < 16; ++i) { const int q = tid + 512 * i, ch = q >> 3, part = q & 7;
            LDSQ unsigned* d = (LDSQ unsigned*)(lds + ch * 132 + part * 16); d[0] = tv[i].x; d[1] = tv[i].y; d[2] = tv[i].z; d[3] = tv[i].w; }
        __syncthreads();
        for (int tk = wid * 8; tk < wid * 8 + 8; ++tk) {
            float va[8], vb[8]; float ssf = 0.f, ssh = 0.f;
#pragma unroll
            for (int e = 0; e < 8; ++e) { const int ch = 2 * lane + 128 * e;
                va[e] = bf2f(*(const LDSQ bf16_t*)(lds + ch * 132 + tk * 2)); vb[e] = bf2f(*(const LDSQ bf16_t*)(lds + (ch + 1) * 132 + tk * 2));
                if (e < 4) ssf += va[e] * va[e] + vb[e] * vb[e]; else ssh += va[e] * va[e] + vb[e] * vb[e]; }
            ssf = wave_sum(ssf); ssh = wave_sum(ssh);
            const float rf = rsqrtf(ssf * (1.0f / 512.0f) + EPSF), rh = rsqrtf(ssh * (1.0f / 512.0f) + EPSF);
#pragma unroll
            for (int e = 0; e < 8; ++e) { const int ch = 2 * lane + 128 * e;
                const float g0 = e < 4 ? gf[ch] : gh[ch - 512], g1 = e < 4 ? gf[ch + 1] : gh[ch + 1 - 512], r = e < 4 ? rf : rh;
                *(unsigned*)(y + (size_t)(tok0 + tk) * DM + ch) = pack2(va[e] * r * g0, vb[e] * r * g1); }
        }
    }
}

#ifndef PHASE_PROGRAM
#define PHASE_PROGRAM {0, 1, 2, 3, 4, 6, 7, 8}
#endif
__global__ __launch_bounds__(512, 2) void hybrid_fwd(Params P) {
    extern __shared__ __attribute__((aligned(16))) unsigned char shm[];
    LDSQ unsigned char* lds = (LDSQ unsigned char*)shm;
    unsigned char* ws = P.ws;
    if (P.ph_lo < 0) cg::this_grid().sync();
    volatile LDSQ unsigned* xbst = (volatile LDSQ unsigned*)(lds + LDS_XB);
    if (threadIdx.x == 0) { xbst[0] = 0u; xbst[1] = 0u; }
    __syncthreads();
    const XcdBarrier xb = xcd_barrier_post((unsigned*)(ws + WS_BAR), xbst);
    constexpr int prog[] = PHASE_PROGRAM;
    constexpr int nprog = (int)(sizeof(prog) / sizeof(int));
#pragma unroll 1
    for (int pi = P.ph_lo; pi < P.ph_hi; ++pi) {
        if (pi > P.ph_lo) xcd_barrier(xb);
        const int ph = prog[pi < nprog ? pi : 0];
        if (ph == 0) {
            LDSQ float* tile = (LDSQ float*)lds; LDSQ float* cs = tile + 64 * 65;
            { const int tq = opaque_tid(); if (tq < 64) { cs[tq] = cospif((float)tq * (1.0f / 32.0f)); cs[64 + tq] = sinpif((float)tq * (1.0f / 32.0f)); } }
            __syncthreads();
            transpose_w(P.in[2], DM, INW, (bf16_t*)(ws + WS_WIN), 512, nullptr, tile, cs);
            transpose_w(P.in[14], DM, DM, (bf16_t*)(ws + WS_WOUT), 0, nullptr, tile, cs);
            transpose_w(P.in[16], DM, DFF, (bf16_t*)(ws + WS_W1), 0, P.in[15], tile, cs);
            transpose_w(P.in[17], DFF, DM, (bf16_t*)(ws + WS_W2), 0, nullptr, tile, cs);
            __syncthreads();
            filter_mlp(P, (float*)(ws + WS_HF), (LDSQ float*)lds);
            rmsnorm_rows<true>(P.in[0], P.in[1], ws + WS_H, NTOK);
        } else if (ph == 1) {
            pg8::StaticOrder S; S.init(INW, NTOK, gridDim.x, blockIdx.x);
            pg8::gemm_phase(lds, pg8::Gemm{(const bf16_t*)(ws + WS_WIN), (const bf16_t*)(ws + WS_H), INW, NTOK, DM}, S, pg8::EpiBf16<0>{(bf16_t*)(ws + WS_PT), NTOK});
        } else if (ph == 2) {
            fft_phase(P, lds);
        } else if (ph == 3) {
            transpose_norm(P, lds);
        } else if (ph == 4) {
            pg8::StaticOrder S; S.init(NTOK, DM, gridDim.x, blockIdx.x);
            pg8::gemm_phase(lds, pg8::Gemm{(const bf16_t*)(ws + WS_Y), (const bf16_t*)(ws + WS_WOUT), NTOK, DM, DM}, S, pg8::EpiResBf16SS<false>{P.in[0], (bf16_t*)(ws + WS_X1), (float*)(ws + WS_SS1), DM});
        } else if (ph == 6) {
            pg8::StaticOrder S; S.init(NTOK, DFF, gridDim.x, blockIdx.x);
            LDSQ float* rsl = (LDSQ float*)(lds + 131072); int pmA = -1, pmB = -1;
            { pg8::Unit uu; for (int i = 0; S.next(i, uu); ++i) { if (pmA < 0) pmA = uu.pm; else if (uu.pm != pmA && pmB < 0) pmB = uu.pm; } }
            { const int tq = opaque_tid(), slot = tq >> 8, pmq = slot ? pmB : pmA;
              if (pmq >= 0) { const f32x4* sp = (const f32x4*)((const float*)(ws + WS_SS1) + (size_t)(pmq * 256 + (tq & 255)) * 16); const f32x4 s4 = (sp[0] + sp[1]) + (sp[2] + sp[3]);
                rsl[tq] = rsqrtf((s4[0] + s4[1] + s4[2] + s4[3]) * (1.0f / 1024.0f) + 1e-5f); } }
            __syncthreads();
            pg8::gemm_phase(lds, pg8::Gemm{(const bf16_t*)(ws + WS_X1), (const bf16_t*)(ws + WS_W1), NTOK, DFF, DM}, S, pg8::EpiScaleRelu2{(bf16_t*)(ws + WS_A), (const float*)(ws + WS_SS1), DFF, rsl, pmA, pmB});
        } else if (ph == 7) {
            pg8::StaticOrder S; S.init(NTOK, DM, gridDim.x, blockIdx.x);
            pg8::gemm_phase(lds, pg8::Gemm{(const bf16_t*)(ws + WS_A), (const bf16_t*)(ws + WS_W2), NTOK, DM, DFF}, S, pg8::EpiResBf16SS<true>{(const void*)(ws + WS_X1), (bf16_t*)(ws + WS_X2), (float*)(ws + WS_SS2), DM});
        } else if (ph == 8) {
            final_norm((const bf16_t*)(ws + WS_X2), (const float*)(ws + WS_SS2), P.in[18], P.out);
        }
    }
}

extern "C" void kernel_launch(void* const* d_in, const int* in_sizes, int n_in, void* d_out, int out_size, void* d_ws, size_t ws_size, hipStream_t stream) {
    static int grid = 0;
    if (grid == 0) {
        if (n_in != 19 || in_sizes[0] != NTOK * DM || out_size != NTOK * DM || ws_size < WS_END) { fprintf(stderr, "kernel_launch: unexpected shapes (n_in %d, in0 %d, out %d, ws %zu)\n", n_in, n_in > 0 ? in_sizes[0] : -1, out_size, ws_size); grid = -1; return; }
        int dev = 0, cus = 0, per_cu = 0;
        hipGetDevice(&dev); hipDeviceGetAttribute(&cus, hipDeviceAttributeMultiprocessorCount, dev);
        if (hipFuncSetAttribute((const void*)hybrid_fwd, hipFuncAttributeMaxDynamicSharedMemorySize, LDS_BYTES) != hipSuccess) { fprintf(stderr, "kernel_launch: hipFuncSetAttribute failed\n"); grid = -1; return; }
        if (hipOccupancyMaxActiveBlocksPerMultiprocessor(&per_cu, (const void*)hybrid_fwd, 512, LDS_BYTES) != hipSuccess || per_cu < 1) { fprintf(stderr, "kernel_launch: occupancy query gave %d\n", per_cu); per_cu = 1; }
        (void)hipGetLastError();
        grid = cus;
    }
    if (grid < 0) return;
    Params p{};
    for (int i = 0; i < 19; ++i) p.in[i] = (const float*)d_in[i];
    p.out = (float*)d_out; p.ws = (unsigned char*)d_ws;
    constexpr int progh[] = PHASE_PROGRAM;
    constexpr int NPH = (int)(sizeof(progh) / sizeof(int));
    if (hipMemsetAsync((unsigned char*)d_ws + WS_BAR, 0, XCD_BAR_WORDS * sizeof(unsigned), stream) != hipSuccess) { fprintf(stderr, "kernel_launch: memset of the barrier words failed\n"); return; }
    for (int li = 0; li < N_LAUNCHES; ++li) {
        p.ph_lo = (N_LAUNCHES == 1) ? 0 : li; p.ph_hi = (N_LAUNCHES == 1) ? NPH : li + 1;
        void* args[] = {&p};
        hipError_t e = hipLaunchCooperativeKernel((const void*)hybrid_fwd, dim3(grid), dim3(512), args, LDS_BYTES, stream);
        if (e != hipSuccess) { fprintf(stderr, "kernel_launch: cooperative launch %d failed: %s (grid %d)\n", li, hipGetErrorString(e), grid); break; }
    }
}
```

```cpp
#include <hip/hip_runtime.h>
#include <hip/hip_cooperative_groups.h>
#include <cstdio>
namespace cg = cooperative_groups;

#ifndef N_LAUNCHES
#define N_LAUNCHES 1
#endif
#define LDSQ __attribute__((address_space(3)))
typedef unsigned short bf16_t;
typedef short bf16x8 __attribute__((ext_vector_type(8)));
typedef float f32x4 __attribute__((ext_vector_type(4)));
typedef unsigned u32x4 __attribute__((ext_vector_type(4)));
typedef unsigned u32x2 __attribute__((ext_vector_type(2)));

constexpr int NB = 8, SEQ = 4096, DM = 1024, NTOK = NB * SEQ, INW = 2048, DFF = 4096;
constexpr float EPSF = 1e-5f;
constexpr size_t MiB = 1024 * 1024;
constexpr size_t WS_H = 0, WS_PT = 64 * MiB, WS_YT = 192 * MiB, WS_Y = 256 * MiB, WS_A = 64 * MiB, WS_X1 = 320 * MiB,
                 WS_WIN = 448 * MiB, WS_WOUT = 452 * MiB, WS_W1 = 454 * MiB, WS_W2 = 462 * MiB, WS_HF = 470 * MiB, WS_BAR = 502 * MiB, WS_SS1 = 503 * MiB, WS_SS2 = 505 * MiB, WS_IRS = 507 * MiB, WS_IG = 507 * MiB + 131072, WS_END = 508 * MiB;
constexpr size_t WS_X2 = WS_X1 + 64 * MiB;
constexpr int LDS_XB = 139264;
constexpr int LDS_BYTES = LDS_XB + 16;


#define XB_TMO      128
#define XB_XCNT(j)  (256  + 64 * (j))
#define XB_XSUB(j)  (1280 + 64 * (j))
#define XB_XGEN(j)  (2304 + 64 * (j))
#define XB_TOP      3328
#define XB_TOPGEN   3392
#define XCD_BAR_WORDS 3456
#define XB_SPIN_CAP (1u << 22)
__device__ __forceinline__ unsigned xb_ld(unsigned* p)              { return __hip_atomic_load(p, __ATOMIC_RELAXED, __HIP_MEMORY_SCOPE_AGENT); }
__device__ __forceinline__ unsigned xb_add(unsigned* p, unsigned v) { return __hip_atomic_fetch_add(p, v, __ATOMIC_RELAXED, __HIP_MEMORY_SCOPE_AGENT); }
__device__ __forceinline__ unsigned xb_xcc_id() { return (unsigned)__builtin_amdgcn_s_getreg((3 << 11) | 20) & 0xFu; }
#define XB_SPIN(cond, bar) do { unsigned _sp = 0; while (cond) { __builtin_amdgcn_s_sleep(1); \
    if ((++_sp & 255u) == 0u) { if (xb_ld(&(bar)[XB_TMO])) break; if (_sp > XB_SPIN_CAP) { atomicAdd(&(bar)[XB_TMO], 1u); break; } } } } while (0)
struct XcdBarrier { unsigned* bar; unsigned x; volatile LDSQ unsigned* st; };
__device__ __forceinline__ XcdBarrier xcd_barrier_post(unsigned* bar, volatile LDSQ unsigned* st) {
    XcdBarrier b; b.bar = bar; b.x = xb_xcc_id(); b.st = st;
    if (threadIdx.x == 0) (void)xb_add(&bar[XB_XCNT(b.x)], 1u);
    return b;
}
__device__ __forceinline__ void xcd_barrier_complete(unsigned* bar, unsigned x, unsigned& nloc, unsigned& nx) {
    const unsigned G = gridDim.x * gridDim.y * gridDim.z;
    unsigned sum, cnt, mine, sp = 0u;
    for (;;) {
        sum = 0u; cnt = 0u; mine = 0u;
#pragma unroll
        for (unsigned j = 0; j < 16; ++j) { const unsigned c = xb_ld(&bar[XB_XCNT(j)]); sum += c; cnt += (c > 0u) ? 1u : 0u; mine = (j == x) ? c : mine; }
        if (sum == G) break;
        __builtin_amdgcn_s_sleep(1);
        if ((++sp & 255u) == 0u) { if (xb_ld(&bar[XB_TMO])) break; if (sp > XB_SPIN_CAP) { atomicAdd(&bar[XB_TMO], 1u); break; } }
    }
    nloc = mine > 0u ? mine : 1u; nx = cnt > 0u ? cnt : 1u;
}
__device__ __forceinline__ void xcd_barrier(const XcdBarrier& b) {
    asm volatile("s_waitcnt vmcnt(0)" ::: "memory");
    __syncthreads();
    if (threadIdx.x == 0) {
        unsigned* bar = b.bar;
        __builtin_amdgcn_s_waitcnt(0);
        unsigned nloc = b.st[0], nx = b.st[1];
        if (nloc == 0u) { xcd_barrier_complete(bar, b.x, nloc, nx); b.st[0] = nloc; b.st[1] = nx; }
        const unsigned old = xb_add(&bar[XB_XSUB(b.x)], 1u);
        const unsigned gen = old / nloc;
        if (old + 1u == (gen + 1u) * nloc) {
            __builtin_amdgcn_fence(__ATOMIC_RELEASE, "agent");
            asm volatile("s_waitcnt vmcnt(0)" ::: "memory");
            const unsigned og = xb_add(&bar[XB_TOP], 1u);
            const unsigned tg = og / nx;
            if (og + 1u == (tg + 1u) * nx) xb_add(&bar[XB_TOPGEN], 1u);
            else XB_SPIN(xb_ld(&bar[XB_TOPGEN]) == tg, bar);
            __builtin_amdgcn_fence(__ATOMIC_ACQUIRE, "agent");
            xb_add(&bar[XB_XGEN(b.x)], 1u);
            asm volatile("s_waitcnt vmcnt(0)" ::: "memory");
        } else {
            XB_SPIN(xb_ld(&bar[XB_XGEN(b.x)]) == gen, bar);
            __builtin_amdgcn_fence(__ATOMIC_ACQUIRE, "agent");
            asm volatile("s_waitcnt vmcnt(0)" ::: "memory");
        }
    }
    __syncthreads();
}

__device__ __forceinline__ int opaque_tid() { int t = threadIdx.x; asm volatile("" : "+v"(t)); return t; }
namespace pg8 {
constexpr int BM = 256, BK = 64, HALF = 128, HTB = HALF * BK * 2, STAGE_BYTES = 8 * HTB, NXCD = 8, WGM = 8;
__host__ __device__ __forceinline__ int lds_byte(int r, int c) { const int st = (r >> 4) * 2 + (c >> 5), rr = r & 15, cc = c & 31, ob = rr * 64 + cc * 2; return st * 1024 + (ob ^ (((ob >> 9) & 1) << 5)); }
__host__ __device__ __forceinline__ void stage_rc(int b, int& R, int& C) { const int st = b / 1024, sb = b % 1024, swz = sb ^ (((sb >> 9) & 1) << 5); R = (st >> 1) * 16 + swz / 64; C = (st & 1) * 32 + (swz % 64) / 2; }
__host__ __device__ __forceinline__ int perm32(int rho) { const int n = rho >> 4, i = rho & 15; return 8 * (i >> 2) + 4 * n + (i & 3); }
struct Unit { int pm, pn; };
struct Gemm { const bf16_t* A; const bf16_t* Bt; int M, N, K; };
struct StaticOrder {
    int nM, nN, nwg, G, c;
    __host__ __device__ void init(int M, int N, int G_, int c_) { nM = M / BM; nN = N / BM; nwg = nM * nN; G = G_; c = c_; }
    __host__ __device__ bool next(int i, Unit& u) const {
        const long L = (long)i * G + c; if (L >= nwg) return false;
        int wgid = (int)L; { const int q = nwg / NXCD, r = nwg % NXCD, xcd = wgid % NXCD, off = wgid / NXCD; wgid = (xcd < r ? xcd * (q + 1) : r * (q + 1) + (xcd - r) * q) + off; }
        const int nig = WGM * nN, gid = wgid / nig, fm = gid * WGM, gsz = (nM - fm) < WGM ? (nM - fm) : WGM;
        u.pm = fm + ((wgid % nig) % gsz); u.pn = (wgid % nig) / gsz; return true;
    }
    __device__ __forceinline__ void a_ready(const Unit&) const {}
    __device__ __forceinline__ void done(const Unit&) const {}
};
__device__ __forceinline__ unsigned cvt_pk_bf16(float lo, float hi) { unsigned r; asm volatile("v_cvt_pk_bf16_f32 %0, %1, %2" : "=v"(r) : "v"(lo), "v"(hi)); return r; }

template <int ACT  > struct EpiBf16 {
    static constexpr bool PERM = true;
    bf16_t* O; int ldc;
    __device__ __forceinline__ void operator()(const f32x4 (&acc)[2][2][4][2], const Unit& u, int wr, int wc, int fr, int fq) const {
        const int row0 = u.pm * BM + wr * 64 + fr; const int col0 = u.pn * BM + wc * 32 + 8 * fq;
#pragma unroll
        for (int ai = 0; ai < 2; ++ai)
#pragma unroll
            for (int m = 0; m < 4; ++m) { bf16_t* rowp = O + (size_t)(row0 + ai * HALF + m * 16) * ldc + col0;
#pragma unroll
                for (int bj = 0; bj < 2; ++bj) { f32x4 v0 = acc[ai][bj][m][0], v1 = acc[ai][bj][m][1];
                    if (ACT == 1) {
#pragma unroll
                        for (int j = 0; j < 4; ++j) { const float a = fmaxf(v0[j], 0.f), b = fmaxf(v1[j], 0.f); v0[j] = a * a; v1[j] = b * b; } }
                    u32x4 w; w.x = cvt_pk_bf16(v0[0], v0[1]); w.y = cvt_pk_bf16(v0[2], v0[3]); w.z = cvt_pk_bf16(v1[0], v1[1]); w.w = cvt_pk_bf16(v1[2], v1[3]);
                    *(u32x4*)(rowp + bj * HALF) = w; } }
    }
};
struct EpiResF32 {
    static constexpr bool PERM = false;
    const float* R; float* C; int ldc;
    __device__ __forceinline__ void operator()(const f32x4 (&acc)[2][2][4][2], const Unit& u, int wr, int wc, int fr, int fq) const {
        const int row0 = u.pm * BM + wr * 64 + fr, col0 = u.pn * BM + wc * 32 + 4 * fq;
#pragma unroll
        for (int ai = 0; ai < 2; ++ai)
#pragma unroll
            for (int m = 0; m < 4; ++m) { const size_t ro = (size_t)(row0 + ai * HALF + m * 16) * ldc + col0;
#pragma unroll
                for (int bj = 0; bj < 2; ++bj)
#pragma unroll
                    for (int n = 0; n < 2; ++n) { const f32x4 r = *(const f32x4*)(R + ro + bj * HALF + n * 16); *(f32x4*)(C + ro + bj * HALF + n * 16) = acc[ai][bj][m][n] + r; } }
    }
};

template <int MODE> struct EpiResBf16SS {
    static constexpr bool PERM = true;
    const bf16_t* R; bf16_t* O; float* ssp; int ldc; const LDSQ float* irl; int pmA, pmB; const float* irs; const float* ig;
    __device__ __forceinline__ void operator()(const f32x4 (&acc)[2][2][4][2], const Unit& u, int wr, int wc, int fr, int fq) const {
        const int row0 = u.pm * BM + wr * 64 + fr; const int col0 = u.pn * BM + wc * 32 + 8 * fq;
        float sc[2][4]; f32x4 g0[2], g1[2];
        if (MODE == 2) {
            if (u.pm == pmA || u.pm == pmB) { const LDSQ float* r = irl + (u.pm == pmA ? 0 : 256) + wr * 64 + fr;
#pragma unroll
                for (int ai = 0; ai < 2; ++ai)
#pragma unroll
                    for (int m = 0; m < 4; ++m) sc[ai][m] = r[ai * HALF + m * 16]; }
            else {
#pragma unroll
                for (int ai = 0; ai < 2; ++ai)
#pragma unroll
                    for (int m = 0; m < 4; ++m) sc[ai][m] = irs[row0 + ai * HALF + m * 16]; }
#pragma unroll
            for (int bj = 0; bj < 2; ++bj) { g0[bj] = *(const f32x4*)(ig + col0 + bj * HALF); g1[bj] = *(const f32x4*)(ig + col0 + bj * HALF + 4); }
        }
#pragma unroll
        for (int ai = 0; ai < 2; ++ai) {
            u32x4 rb[4][2];
#pragma unroll
            for (int m = 0; m < 4; ++m) { const size_t ro = (size_t)(row0 + ai * HALF + m * 16) * ldc + col0;
#pragma unroll
                for (int bj = 0; bj < 2; ++bj) rb[m][bj] = *(const u32x4*)(R + ro + bj * HALF); }
#pragma unroll
            for (int m = 0; m < 4; ++m) { const int row = row0 + ai * HALF + m * 16; const size_t ro = (size_t)row * ldc + col0; float ss = 0.f;
#pragma unroll
                for (int bj = 0; bj < 2; ++bj) { f32x4 v0 = acc[ai][bj][m][0], v1 = acc[ai][bj][m][1]; const u32x4 r = rb[m][bj];
                    f32x4 r0, r1;
                    r0[0] = __uint_as_float(r.x << 16); r0[1] = __uint_as_float(r.x & 0xffff0000u); r0[2] = __uint_as_float(r.y << 16); r0[3] = __uint_as_float(r.y & 0xffff0000u);
                    r1[0] = __uint_as_float(r.z << 16); r1[1] = __uint_as_float(r.z & 0xffff0000u); r1[2] = __uint_as_float(r.w << 16); r1[3] = __uint_as_float(r.w & 0xffff0000u);
                    if (MODE == 2) { v0 += r0 * (g0[bj] * sc[ai][m]); v1 += r1 * (g1[bj] * sc[ai][m]); } else { v0 += r0; v1 += r1; }
#pragma unroll
                    for (int j = 0; j < 4; ++j) ss += v0[j] * v0[j] + v1[j] * v1[j];
                    u32x4 w; w.x = cvt_pk_bf16(v0[0], v0[1]); w.y = cvt_pk_bf16(v0[2], v0[3]); w.z = cvt_pk_bf16(v1[0], v1[1]); w.w = cvt_pk_bf16(v1[2], v1[3]);
                    *(u32x4*)(O + ro + bj * HALF) = w; }
                ss += __shfl_xor(ss, 16, 64); ss += __shfl_xor(ss, 32, 64);
                if (fq == 0) ssp[(size_t)row * 16 + u.pn * 4 + wc] = ss; }
        }
    }
};
struct EpiScaleRelu2 {
    static constexpr bool PERM = true;
    bf16_t* O; const float* ssp; int ldc; const LDSQ float* rsl; int pmA, pmB;
    __device__ __forceinline__ void operator()(const f32x4 (&acc)[2][2][4][2], const Unit& u, int wr, int wc, int fr, int fq) const {
        const int row0 = u.pm * BM + wr * 64 + fr; const int col0 = u.pn * BM + wc * 32 + 8 * fq;
        float rs[2][4];
        if (u.pm == pmA || u.pm == pmB) { const LDSQ float* r = rsl + (u.pm == pmA ? 0 : 256) + wr * 64 + fr;
#pragma unroll
            for (int ai = 0; ai < 2; ++ai)
#pragma unroll
                for (int m = 0; m < 4; ++m) rs[ai][m] = r[ai * HALF + m * 16]; }
        else {
#pragma unroll
            for (int ai = 0; ai < 2; ++ai)
#pragma unroll
                for (int m = 0; m < 4; ++m) { const f32x4* sp = (const f32x4*)(ssp + (size_t)(row0 + ai * HALF + m * 16) * 16); const f32x4 s4 = (sp[0] + sp[1]) + (sp[2] + sp[3]);
                    rs[ai][m] = rsqrtf((s4[0] + s4[1] + s4[2] + s4[3]) * (1.0f / 1024.0f) + 1e-5f); } }
#pragma unroll
        for (int ai = 0; ai < 2; ++ai)
#pragma unroll
            for (int m = 0; m < 4; ++m) { const int row = row0 + ai * HALF + m * 16; bf16_t* rowp = O + (size_t)row * ldc + col0; const float s = rs[ai][m];
#pragma unroll
                for (int bj = 0; bj < 2; ++bj) { f32x4 v0 = acc[ai][bj][m][0], v1 = acc[ai][bj][m][1];
#pragma unroll
                    for (int j = 0; j < 4; ++j) { const float a = fmaxf(v0[j] * s, 0.f), b = fmaxf(v1[j] * s, 0.f); v0[j] = a * a; v1[j] = b * b; }
                    u32x4 w; w.x = cvt_pk_bf16(v0[0], v0[1]); w.y = cvt_pk_bf16(v0[2], v0[3]); w.z = cvt_pk_bf16(v1[0], v1[1]); w.w = cvt_pk_bf16(v1[2], v1[3]);
                    *(u32x4*)(rowp + bj * HALF) = w; } }
    }
};

template <class Epi, class Sched>
__device__ __forceinline__ void gemm_phase(LDSQ unsigned char* lds, const Gemm g, const Sched& S, const Epi& E) {
    const int tid = opaque_tid(), wid = __builtin_amdgcn_readfirstlane(tid >> 6), lane = tid & 63, wr = wid >> 2, wc = wid & 3, fr = lane & 15, fq = lane >> 4;
    const int K = g.K, nt = K / BK;
    unsigned voffA[2], voffB[2];
#pragma unroll
    for (int i = 0; i < 2; ++i) { int R, C; stage_rc(tid * 16 + i * 8192, R, C); const int Rb = Epi::PERM ? ((R & ~31) + perm32(R & 31)) : R;
        voffA[i] = (unsigned)(R * K + C) * 2u; voffB[i] = (unsigned)(Rb * K + C) * 2u; }
    const size_t kstep = (size_t)(BK * 2);
    const size_t hstep = (size_t)HALF * K * 2;
    const size_t tstep = 2 * hstep;
    const unsigned ldsw = (unsigned)wid * 1024u;
    const int aoff = lds_byte(wr * 64 + fr, fq * 8), boff = lds_byte(wc * 32 + fr, fq * 8);
#define PG8_SA(b, h) (((b) * 2 + (h)) * HTB)
#define PG8_SB(b, h) ((4 + (b) * 2 + (h)) * HTB)
#define PG8_STAGE(bufoff, gbase, voff) do { _Pragma("unroll") for (int _i = 0; _i < 2; ++_i) \
        __builtin_amdgcn_global_load_lds((const unsigned*)((const char*)(gbase) + (voff)[_i]), (LDSQ unsigned*)(lds + (bufoff) + ldsw + _i * 8192), 16, 0, 0); } while (0)
#define PG8_LDA(dst, b, h) do { _Pragma("unroll") for (int m = 0; m < 4; ++m) _Pragma("unroll") for (int k = 0; k < 2; ++k) dst[m][k] = *(const LDSQ bf16x8*)(lds + PG8_SA(b, h) + aoff + m * 2048 + k * 1024); } while (0)
#define PG8_LDB(dst, b, h) do { _Pragma("unroll") for (int n = 0; n < 2; ++n) _Pragma("unroll") for (int k = 0; k < 2; ++k) dst[n][k] = *(const LDSQ bf16x8*)(lds + PG8_SB(b, h) + boff + n * 2048 + k * 1024); } while (0)
#define PG8_MMA(ai, bj, At, Bt) do { __builtin_amdgcn_s_setprio(1); _Pragma("unroll") for (int m = 0; m < 4; ++m) _Pragma("unroll") for (int n = 0; n < 2; ++n) _Pragma("unroll") for (int k = 0; k < 2; ++k) \
        acc[ai][bj][m][n] = __builtin_amdgcn_mfma_f32_16x16x32_bf16(Bt[n][k], At[m][k], acc[ai][bj][m][n], 0, 0, 0); __builtin_amdgcn_s_setprio(0); } while (0)
#define PG8_WAIT_V(n) asm volatile("s_waitcnt vmcnt(" #n ")" ::: "memory")
#define PG8_WAIT_L(n) asm volatile("s_waitcnt lgkmcnt(" #n ")" ::: "memory")
#define PG8_BAR __builtin_amdgcn_s_barrier()
#define PG8_SCHED __builtin_amdgcn_sched_barrier(0)
    Unit cur, nxt; int ui = 0;
    if (!S.next(0, cur)) return;
    f32x4 acc[2][2][4][2];
#pragma unroll
    for (int a = 0; a < 2; ++a)
#pragma unroll
        for (int b = 0; b < 2; ++b)
#pragma unroll
            for (int m = 0; m < 4; ++m)
#pragma unroll
                for (int n = 0; n < 2; ++n) acc[a][b][m][n] = (f32x4){0.f, 0.f, 0.f, 0.f};
    bf16x8 At[4][2], B0[2][2], B1[2][2];
    const char* cA = (const char*)g.A + (size_t)cur.pm * tstep; const char* cB = (const char*)g.Bt + (size_t)cur.pn * tstep;
    S.a_ready(cur);
    PG8_STAGE(PG8_SB(0, 0), cB, voffB); PG8_STAGE(PG8_SA(0, 0), cA, voffA); PG8_STAGE(PG8_SB(0, 1), cB + hstep, voffB); PG8_STAGE(PG8_SA(0, 1), cA + hstep, voffA);
    if (wr == 1) PG8_BAR;
    PG8_WAIT_V(4); PG8_BAR;
    PG8_STAGE(PG8_SB(1, 0), cB + kstep, voffB); PG8_STAGE(PG8_SA(1, 0), cA + kstep, voffA); PG8_STAGE(PG8_SB(1, 1), cB + hstep + kstep, voffB);
    PG8_WAIT_V(6); PG8_BAR;
    for (;;) {
        const bool has_next = S.next(ui + 1, nxt);
        const char* nA = has_next ? (const char*)g.A + (size_t)nxt.pm * tstep : cA; const char* nB = has_next ? (const char*)g.Bt + (size_t)nxt.pn * tstep : cB;
        for (int t = 0; t < nt; t += 2) {
            const bool last = (t == nt - 2);
            const char* a1 = cA + (size_t)(t + 1) * kstep;
            const char* a2 = last ? nA : cA + (size_t)(t + 2) * kstep; const char* b2 = last ? nB : cB + (size_t)(t + 2) * kstep;
            const char* a3 = a2 + kstep; const char* b3 = b2 + kstep;
            if (last && has_next) S.a_ready(nxt);
            PG8_LDB(B0, 0, 0); PG8_SCHED; PG8_LDA(At, 0, 0); PG8_STAGE(PG8_SA(1, 1), a1 + hstep, voffA);
            PG8_WAIT_L(8); PG8_BAR; PG8_WAIT_L(0); PG8_MMA(0, 0, At, B0); PG8_BAR; PG8_SCHED;
            PG8_LDB(B1, 0, 1); PG8_STAGE(PG8_SB(0, 0), b2, voffB);
            PG8_BAR; PG8_WAIT_L(0); PG8_MMA(0, 1, At, B1); PG8_BAR;
            PG8_LDA(At, 0, 1); PG8_STAGE(PG8_SA(0, 0), a2, voffA);
            PG8_BAR; PG8_WAIT_L(0); PG8_MMA(1, 0, At, B0); PG8_BAR; PG8_SCHED;
            PG8_STAGE(PG8_SB(0, 1), b2 + hstep, voffB);
            PG8_WAIT_V(6); PG8_BAR; PG8_MMA(1, 1, At, B1); PG8_BAR;
            PG8_LDB(B0, 1, 0); PG8_SCHED; PG8_LDA(At, 1, 0); PG8_STAGE(PG8_SA(0, 1), a2 + hstep, voffA);
            PG8_WAIT_L(8); PG8_BAR; PG8_WAIT_L(0); PG8_MMA(0, 0, At, B0); PG8_BAR; PG8_SCHED;
            PG8_LDB(B1, 1, 1); PG8_STAGE(PG8_SB(1, 0), b3, voffB);
            PG8_BAR; PG8_WAIT_L(0); PG8_MMA(0, 1, At, B1); PG8_BAR;
            PG8_LDA(At, 1, 1); PG8_STAGE(PG8_SA(1, 0), a3, voffA);
            PG8_BAR; PG8_WAIT_L(0); PG8_MMA(1, 0, At, B0); PG8_BAR; PG8_SCHED;
            PG8_STAGE(PG8_SB(1, 1), b3 + hstep, voffB);
            PG8_WAIT_V(6); PG8_BAR; PG8_MMA(1, 1, At, B1); PG8_BAR;
        }
        E(acc, cur, wr, wc, fr, fq); S.done(cur);
        if (!has_next) break;
#pragma unroll
        for (int a = 0; a < 2; ++a)
#pragma unroll
            for (int b = 0; b < 2; ++b)
#pragma unroll
                for (int m = 0; m < 4; ++m)
#pragma unroll
                    for (int n = 0; n < 2; ++n) acc[a][b][m][n] = (f32x4){0.f, 0.f, 0.f, 0.f};
        cur = nxt; cA = nA; cB = nB; ++ui;
    }
    PG8_WAIT_V(0);
    if (wr == 0) PG8_BAR;
    PG8_BAR;
#undef PG8_SA
#undef PG8_SB
#undef PG8_STAGE
#undef PG8_LDA
#undef PG8_LDB
#undef PG8_MMA
#undef PG8_WAIT_V
#undef PG8_WAIT_L
#undef PG8_BAR
#undef PG8_SCHED
}
}

typedef float f2 __attribute__((ext_vector_type(2)));
#define HD __host__ __device__ __forceinline__

HD f2 cmul(f2 a, f2 b) { const f2 t = (f2){a.x, a.x} * b; return (f2){a.y, a.y} * (f2){-b.y, b.x} + t; }
HD f2 cmulc(f2 a, f2 b) { const f2 t = (f2){a.x, a.x} * (f2){b.x, -b.y}; return (f2){a.y, a.y} * (f2){b.y, b.x} + t; }
HD f2 cconj(f2 a) { return (f2){a.x, -a.y}; }
HD f2 twid(float x) {
#ifdef __HIP_DEVICE_COMPILE__
    return (f2){cospif(x), -sinpif(x)};
#else
    return (f2){(float)cos(3.14159265358979323846 * (double)x), (float)-sin(3.14159265358979323846 * (double)x)};
#endif
}
HD constexpr int rev16(int i) { return (i >> 2) | ((i & 3) << 2); }

template <bool INV> HD void bfly4(f2& x0, f2& x1, f2& x2, f2& x3) {
    const f2 t0 = x0 + x2, t1 = x0 - x2, t2 = x1 + x3, t3 = x1 - x3;
    const f2 it3 = INV ? (f2){-t3.y, t3.x} : (f2){t3.y, -t3.x};
    x0 = t0 + t2; x1 = t1 + it3; x2 = t0 - t2; x3 = t1 - it3;
}
template <bool INV> HD f2 mulw(f2 z, float c, float s) {
    const float ss = INV ? s : -s;
    const f2 zr = (f2){-z.y, z.x};
    return z * c + zr * ss;
}
template <bool INV> HD void fft16(f2 (&v)[16]) {
#pragma unroll
    for (int j = 0; j < 4; ++j) bfly4<INV>(v[j], v[j + 4], v[j + 8], v[j + 12]);
    const float C1 = 0.92387953251128674f, S1 = 0.38268343236508977f, H = 0.70710678118654752f;
    v[5] = mulw<INV>(v[5], C1, S1);  v[9] = mulw<INV>(v[9], H, H);     v[13] = mulw<INV>(v[13], S1, C1);
    v[6] = mulw<INV>(v[6], H, H);    v[10] = mulw<INV>(v[10], 0.f, 1.f); v[14] = mulw<INV>(v[14], -H, H);
    v[7] = mulw<INV>(v[7], S1, C1);  v[11] = mulw<INV>(v[11], -H, H);  v[15] = mulw<INV>(v[15], -C1, -S1);
#pragma unroll
    for (int q = 0; q < 4; ++q) bfly4<INV>(v[4 * q], v[4 * q + 1], v[4 * q + 2], v[4 * q + 3]);
}
HD int opq(int t) {
#ifdef __HIP_DEVICE_COMPILE__
    asm volatile("" : "+v"(t));
#endif
    return t;
}
HD f2 opq2(f2 w) {
#ifdef __HIP_DEVICE_COMPILE__
    asm volatile("" : "+v"(w.x), "+v"(w.y));
#endif
    return w;
}
HD void tw_table(f2 base, f2 w1, f2 (&p)[16]) {
    w1 = opq2(w1); base = opq2(base);
    const f2 q2 = cmul(w1, w1), q4 = cmul(q2, q2), q8 = cmul(q4, q4);
    p[0] = base; p[1] = cmul(base, w1); p[2] = cmul(p[0], q2); p[3] = cmul(p[1], q2);
#pragma unroll
    for (int e = 0; e < 4; ++e) p[4 + e] = cmul(p[e], q4);
#pragma unroll
    for (int e = 0; e < 8; ++e) p[8 + e] = cmul(p[e], q8);
}
template <int STRIDE> HD void apply_store(const f2 (&v)[16], const f2 (&p)[16], LDSQ f2* a) {
#pragma unroll
    for (int e = 0; e < 16; ++e) a[STRIDE * e] = cmul(v[rev16(e)], p[e]);
}
template <int STRIDE> HD void apply_store_conj(const f2 (&v)[16], const f2 (&p)[16], LDSQ f2* a) {
#pragma unroll
    for (int e = 0; e < 16; ++e) a[STRIDE * e] = cmulc(v[rev16(e)], p[e]);
}
template <int STRIDE, bool INV> HD void read_fft(LDSQ f2* a, f2 (&v)[16]) {
#pragma unroll
    for (int i = 0; i < 16; ++i) v[i] = a[STRIDE * i];
    fft16<INV>(v);
}
HD LDSQ f2* base_p1(LDSQ f2* arr, int t) { t = opq(t) & 255; return arr + (t + (t >> 4)); }
HD LDSQ f2* base_p2(LDSQ f2* arr, int t) { t = opq(t) & 255; return arr + (272 * (t >> 4) + (t & 15)); }
HD LDSQ f2* base_p3(LDSQ f2* arr, int t) { t = opq(t) & 255; return arr + 17 * t; }

struct FftTw { f2 w_p1, w_p2, b_i2, w_i2; };
HD FftTw make_tw(int t) {
    const int k0 = t >> 4, n0 = t & 15;
    FftTw w;
    w.w_p1 = twid((float)t * (1.0f / 2048.0f));
    w.w_p2 = twid((float)n0 * (1.0f / 128.0f));
    w.b_i2 = cconj(twid((float)(n0 * k0) * (1.0f / 2048.0f)));
    w.w_i2 = cconj(twid((float)k0 * (1.0f / 128.0f)));
    return w;
}

__device__ __forceinline__ float bf2f(bf16_t b) { return __uint_as_float(((unsigned)b) << 16); }
__device__ __forceinline__ bf16_t f2bf(float f) { unsigned u = __float_as_uint(f); u += 0x7FFFu + ((u >> 16) & 1u); return (bf16_t)(u >> 16); }
__device__ __forceinline__ unsigned pack2(float lo, float hi) { return (unsigned)f2bf(lo) | ((unsigned)f2bf(hi) << 16); }
__device__ __forceinline__ float wave_sum(float v) {
#pragma unroll
    for (int o = 32; o > 0; o >>= 1) v += __shfl_xor(v, o, 64);
    return v;
}
__device__ __forceinline__ float sin_acc(float x) { return sinpif(x * 0.31830988618379067f); }

struct Params {
    const float* in[19];
    float* out;
    unsigned char* ws;
    int ph_lo, ph_hi;
};

__device__ __forceinline__ void transpose_w(const float* __restrict__ src, int K, int N, bf16_t* __restrict__ dst, int premix_cols, const float* __restrict__ kscale, LDSQ float* tile, LDSQ float* cs) {
    const int tid = opaque_tid(), ntk = K / 64, ntn = N / 64, ntl = ntk * ntn;
    const int r0 = tid >> 4, c4 = tid & 15;
    f32x4 nx0, nx1;
    int tl = blockIdx.x;
    if (tl < ntl) { const int k0 = (tl % ntk) * 64, n0 = (tl / ntk) * 64;
        nx0 = *(const f32x4*)(src + (size_t)(k0 + r0) * N + n0 + c4 * 4); nx1 = *(const f32x4*)(src + (size_t)(k0 + r0 + 32) * N + n0 + c4 * 4); }
    for (; tl < ntl; tl += gridDim.x) {
        const int kt = tl % ntk, nt = tl / ntk, k0 = kt * 64, n0 = nt * 64;
        __syncthreads();
        tile[r0 * 65 + c4 * 4 + 0] = nx0[0]; tile[r0 * 65 + c4 * 4 + 1] = nx0[1]; tile[r0 * 65 + c4 * 4 + 2] = nx0[2]; tile[r0 * 65 + c4 * 4 + 3] = nx0[3];
        tile[(r0 + 32) * 65 + c4 * 4 + 0] = nx1[0]; tile[(r0 + 32) * 65 + c4 * 4 + 1] = nx1[1]; tile[(r0 + 32) * 65 + c4 * 4 + 2] = nx1[2]; tile[(r0 + 32) * 65 + c4 * 4 + 3] = nx1[3];
        __syncthreads();
        { const int tn = tl + gridDim.x;
          if (tn < ntl) { const int k1 = (tn % ntk) * 64, n1 = (tn / ntk) * 64;
            nx0 = *(const f32x4*)(src + (size_t)(k1 + r0) * N + n1 + c4 * 4); nx1 = *(const f32x4*)(src + (size_t)(k1 + r0 + 32) * N + n1 + c4 * 4); } }
        const int n = tid >> 3, kc = tid & 7;
        float o[8];
        if (n0 < premix_cols) {
#pragma unroll
            for (int e = 0; e < 8; ++e) o[e] = 0.f;
#pragma unroll 2
            for (int c = 0; c < 64; ++c) {
                const float mcoef = (n <= 32) ? cs[(c * n) & 63] : -cs[64 + ((c * (n - 32)) & 63)];
#pragma unroll
                for (int e = 0; e < 8; ++e) o[e] += tile[(kc * 8 + e) * 65 + c] * mcoef;
            }
#pragma unroll
            for (int e = 0; e < 8; ++e) o[e] *= (1.0f / 512.0f);
        } else {
#pragma unroll
            for (int e = 0; e < 8; ++e) o[e] = tile[(kc * 8 + e) * 65 + n];
        }
        if (kscale) {
#pragma unroll
            for (int e = 0; e < 8; ++e) o[e] *= kscale[k0 + kc * 8 + e]; }
        u32x4 w; w.x = pack2(o[0], o[1]); w.y = pack2(o[2], o[3]); w.z = pack2(o[4], o[5]); w.w = pack2(o[6], o[7]);
        *(u32x4*)(dst + (size_t)(n0 + n) * K + k0 + kc * 8) = w;
    }
}

template <bool OUT_BF16>
__device__ __forceinline__ void rmsnorm_rows(const float* X, const float* __restrict__ g, void* outp, int rows, float* __restrict__ irs_out) {
    const int tid0 = opaque_tid(), lane = tid0 & 63, wid = tid0 >> 6;
    for (int row = (blockIdx.x * 8 + wid) * 4; row < rows; row += gridDim.x * 32) {
        f32x4 v[4][4]; float ss[4] = {0.f, 0.f, 0.f, 0.f};
#pragma unroll
        for (int q = 0; q < 4; ++q) { const f32x4* xr = (const f32x4*)(X + (size_t)(row + q) * DM);
#pragma unroll
            for (int i = 0; i < 4; ++i) v[q][i] = __builtin_nontemporal_load(xr + lane + 64 * i); }
#pragma unroll
        for (int q = 0; q < 4; ++q) {
#pragma unroll
            for (int i = 0; i < 4; ++i) ss[q] += v[q][i][0] * v[q][i][0] + v[q][i][1] * v[q][i][1] + v[q][i][2] * v[q][i][2] + v[q][i][3] * v[q][i][3];
            ss[q] = wave_sum(ss[q]); }
#pragma unroll
        for (int q = 0; q < 4; ++q) { const float rs = rsqrtf(ss[q] * (1.0f / DM) + EPSF);
            if (irs_out && lane == 0) irs_out[row + q] = 1.0f / rs;
#pragma unroll
            for (int i = 0; i < 4; ++i) { const f32x4 gg = ((const f32x4*)g)[lane + 64 * i]; const f32x4 o = v[q][i] * rs * gg;
                if (OUT_BF16) { u32x2 w; w.x = pack2(o[0], o[1]); w.y = pack2(o[2], o[3]); *(u32x2*)((bf16_t*)outp + (size_t)(row + q) * DM + (lane + 64 * i) * 4) = w; }
                else *(f32x4*)((float*)outp + (size_t)(row + q) * DM + (lane + 64 * i) * 4) = o; } }
    }
}

__device__ __forceinline__ void final_norm(const bf16_t* __restrict__ X, const float* __restrict__ ssp, const float* __restrict__ g, float* __restrict__ out) {
    const int tid0 = opaque_tid(), lane = tid0 & 63, wid = tid0 >> 6;
    f32x4 g0[2], g1[2];
#pragma unroll
    for (int i = 0; i < 2; ++i) { const int c0 = (lane + 64 * i) * 8; g0[i] = *(const f32x4*)(g + c0); g1[i] = *(const f32x4*)(g + c0 + 4); }
    for (int row = (blockIdx.x * 8 + wid) * 4; row < NTOK; row += gridDim.x * 32) {
        u32x4 r[4][2]; f32x4 s4[4];
#pragma unroll
        for (int q = 0; q < 4; ++q) { const f32x4* sp = (const f32x4*)(ssp + (size_t)(row + q) * 16); s4[q] = (sp[0] + sp[1]) + (sp[2] + sp[3]);
#pragma unroll
            for (int i = 0; i < 2; ++i) r[q][i] = *(const u32x4*)(X + (size_t)(row + q) * DM + (lane + 64 * i) * 8); }
#pragma unroll
        for (int q = 0; q < 4; ++q) { const float rs = rsqrtf((s4[q][0] + s4[q][1] + s4[q][2] + s4[q][3]) * (1.0f / DM) + EPSF);
#pragma unroll
            for (int i = 0; i < 2; ++i) { const int c0 = (lane + 64 * i) * 8; const u32x4 rr = r[q][i];
                f32x4 o0, o1;
                o0[0] = __uint_as_float(rr.x << 16); o0[1] = __uint_as_float(rr.x & 0xffff0000u); o0[2] = __uint_as_float(rr.y << 16); o0[3] = __uint_as_float(rr.y & 0xffff0000u);
                o1[0] = __uint_as_float(rr.z << 16); o1[1] = __uint_as_float(rr.z & 0xffff0000u); o1[2] = __uint_as_float(rr.w << 16); o1[3] = __uint_as_float(rr.w & 0xffff0000u);
                *(f32x4*)(out + (size_t)(row + q) * DM + c0) = o0 * rs * g0[i]; *(f32x4*)(out + (size_t)(row + q) * DM + c0 + 4) = o1 * rs * g1[i]; } }
    }
}

__device__ __forceinline__ void filter_mlp(const Params& P, float* __restrict__ hfilt, LDSQ float* lds) {
    const float* wout = P.in[10];
    LDSQ float* zf = lds; LDSQ float* ha = lds + 544; LDSQ float* hb = ha + 1024; LDSQ float* hT = hb + 1024;
    LDSQ float* w0s = hT + 1024; LDSQ float* wis = w0s + 2112; LDSQ float* b0s = wis + 8192; LDSQ float* bis = b0s + 64; LDSQ float* frs = bis + 128;
    const int tid = opaque_tid();
    __syncthreads();
    for (int i = tid; i < 2112; i += 512) w0s[i] = P.in[5][i];
    for (int i = tid; i < 8192; i += 512) wis[i] = P.in[7][i];
    if (tid < 64) { b0s[tid] = P.in[6][tid]; frs[tid] = P.in[9][tid]; }
    if (tid < 128) bis[tid] = P.in[8][tid];
    for (int blk = blockIdx.x; blk < SEQ / 16; blk += gridDim.x) {
        const int l0 = blk * 16;
        __syncthreads();
        for (int idx = tid; idx < 16 * 33; idx += 512) {
            const int l = idx / 33, f = idx - l * 33, pos = l0 + l; float val;
            if (f == 0) val = (float)pos / 4095.0f;
            else { const int j = (f - 1) & 15; const float band = 1e-4f + (float)j * ((15.0f - 1e-4f) / 15.0f); const float x = ((float)pos * (1.0f / 2048.0f)) * band;
                val = (f <= 16) ? cospif(x) : -sinpif(x); }
            zf[idx] = val;
        }
        __syncthreads();
#pragma unroll
        for (int r = 0; r < 2; ++r) { const int idx = tid + 512 * r, l = idx >> 6, u = idx & 63; float s = b0s[u];
#pragma unroll 11
            for (int f = 0; f < 33; ++f) s += zf[l * 33 + f] * w0s[f * 64 + u];
            ha[idx] = sin_acc(frs[u] * s); }
        __syncthreads();
#pragma unroll
        for (int r = 0; r < 2; ++r) { const int idx = tid + 512 * r, l = idx >> 6, u = idx & 63; float s = bis[u];
#pragma unroll 16
            for (int i = 0; i < 64; ++i) s += ha[l * 64 + i] * wis[i * 64 + u];
            hb[idx] = sin_acc(frs[u] * s); }
        __syncthreads();
#pragma unroll
        for (int r = 0; r < 2; ++r) { const int idx = tid + 512 * r, l = idx >> 6, u = idx & 63; float s = bis[64 + u];
#pragma unroll 16
            for (int i = 0; i < 64; ++i) s += hb[l * 64 + i] * wis[4096 + i * 64 + u];
            hT[u * 16 + l] = sin_acc(frs[u] * s); }
        __syncthreads();
        {
            const int lane = tid & 63, wvi = tid >> 6, li = lane & 15, lk = lane >> 4;
            float av[16];
#pragma unroll
            for (int st = 0; st < 16; ++st) av[st] = hT[(4 * st + lk) * 16 + li];
            const float dmin = -3.0701134573253945f, dmax = -15.350567286626973f;
#pragma unroll 1
            for (int ct0 = 0; ct0 < 16; ct0 += 2) {
                float bv[2][16];
#pragma unroll
                for (int q = 0; q < 2; ++q) { const int col0 = (wvi * 16 + ct0 + q) * 16;
#pragma unroll
                    for (int st = 0; st < 16; ++st) bv[q][st] = wout[(4 * st + lk) * 2048 + col0 + li]; }
#pragma unroll
                for (int q = 0; q < 2; ++q) { const int col = (wvi * 16 + ct0 + q) * 16 + li;
                    f32x4 d = (f32x4){0.f, 0.f, 0.f, 0.f};
#pragma unroll
                    for (int st = 0; st < 16; ++st) d = __builtin_amdgcn_mfma_f32_16x16x4f32(av[st], bv[q][st], d, 0, 0, 0);
                    const float delta = fabsf(dmin + (float)(col & 511) * ((dmax - dmin) / 511.0f));
                    float dec = expf(-((float)(l0 + 4 * lk) / 4095.0f) * delta); const float rstep = expf(-delta / 4095.0f);
                    f32x4 o;
                    o[0] = d[0] * dec; dec *= rstep; o[1] = d[1] * dec; dec *= rstep; o[2] = d[2] * dec; dec *= rstep; o[3] = d[3] * dec;
                    *(f32x4*)(hfilt + (size_t)col * SEQ + l0 + 4 * lk) = o; }
            }
        }
    }
}

struct Raw8 { u32x4 a, b; unsigned la, ra, lb, rb; };
__device__ __forceinline__ void load_raw8(const bf16_t* __restrict__ pa, const bf16_t* __restrict__ pb, int tl, Raw8& r) {
    const int il = tl > 0 ? 8 * tl - 1 : 0, ir = tl < 511 ? 8 * tl + 8 : 8 * tl + 7;
    r.a = *(const u32x4*)(pa + 8 * tl); r.b = *(const u32x4*)(pb + 8 * tl);
    r.la = pa[il]; r.ra = pa[ir]; r.lb = pb[il]; r.rb = pb[ir];
}
__device__ __forceinline__ void sconv8(const u32x4 r, unsigned l, unsigned rr, int tl, float w0, float w1, float w2, float bias, float (&u)[8]) {
    float x[10];
    x[1] = __uint_as_float(r.x << 16); x[2] = __uint_as_float(r.x & 0xffff0000u); x[3] = __uint_as_float(r.y << 16); x[4] = __uint_as_float(r.y & 0xffff0000u);
    x[5] = __uint_as_float(r.z << 16); x[6] = __uint_as_float(r.z & 0xffff0000u); x[7] = __uint_as_float(r.w << 16); x[8] = __uint_as_float(r.w & 0xffff0000u);
    x[0] = tl > 0 ? __uint_as_float(l << 16) : 0.f; x[9] = tl < 511 ? __uint_as_float(rr << 16) : 0.f;
#pragma unroll
    for (int i = 0; i < 8; ++i) u[i] = w0 * x[i] + w1 * x[i + 1] + w2 * x[i + 2] + bias;
}
#define FFT_PIN() __builtin_amdgcn_sched_barrier(0)
template <bool KLDS>
__device__ __forceinline__ void conv4096(LDSQ f2* arr, int t, const FftTw& w, const f2 (&K)[16], const LDSQ f2* Kl  ) {
    f2 p[16], v[16];
    tw_table((f2){1.f, 0.f}, w.w_p1, p);
    __syncthreads();
    { LDSQ f2* a = base_p1(arr, t); read_fft<272, false>(a, v); apply_store<272>(v, p, a); }
    FFT_PIN(); tw_table((f2){1.f, 0.f}, w.w_p2, p); __syncthreads();
    { LDSQ f2* a = base_p2(arr, t); read_fft<17, false>(a, v); apply_store<17>(v, p, a); }
    __syncthreads();
    { LDSQ f2* a = base_p3(arr, t); read_fft<1, false>(a, v);
      f2 u[16];
#pragma unroll
      for (int i = 0; i < 16; ++i) u[rev16(i)] = cmul(v[i], KLDS ? Kl[512 * i] : K[i]);
      fft16<true>(u); apply_store_conj<1>(u, p, a); }
    FFT_PIN(); tw_table(w.b_i2, w.w_i2, p); __syncthreads();
    { LDSQ f2* a = base_p2(arr, t); read_fft<17, true>(a, v); apply_store<17>(v, p, a); }
    __syncthreads();
    { LDSQ f2* a = base_p1(arr, t); read_fft<272, true>(a, v);
#pragma unroll
      for (int i = 0; i < 16; ++i) a[272 * rev16(i)] = v[i]; }
    __syncthreads();
}
struct FRaw { f32x4 f0, f1, r0, r1; float b0; };
__device__ __forceinline__ void load_fraw(const float* __restrict__ hf, const float* __restrict__ hb, int tl, FRaw& r) {
    r.f0 = *(const f32x4*)(hf + 8 * tl); r.f1 = *(const f32x4*)(hf + 8 * tl + 4);
    r.r0 = *(const f32x4*)(hb + 4088 - 8 * tl); r.r1 = *(const f32x4*)(hb + 4092 - 8 * tl);
    r.b0 = hb[(SEQ - 8 * tl) & (SEQ - 1)];
}
__device__ __forceinline__ void filter_spec(FRaw& fr, const float* __restrict__ nhf, const float* __restrict__ nhb, float dskip, LDSQ f2* E, LDSQ f2* O, LDSQ float* red, LDSQ f2* arr, int tid, int t, const FftTw& w, f2 wt, f2 (&K)[16]) {
    const f2 WSTEP = (f2){0.9999997058628822f, -0.0007669903187427045f};
    const int tl = opq(tid) & 511, pe = 8 * tl + (tl >> 1);
    float ss = 0.f; f2 tw = opq2(wt);
    float f[8], bb[8];
    { const f32x4 f0 = fr.f0, f1 = fr.f1, r0 = fr.r0, r1 = fr.r1;
      f[0] = f0[0]; f[1] = f0[1]; f[2] = f0[2]; f[3] = f0[3]; f[4] = f1[0]; f[5] = f1[1]; f[6] = f1[2]; f[7] = f1[3];
      bb[0] = fr.b0;
      bb[1] = r1[3]; bb[2] = r1[2]; bb[3] = r1[1]; bb[4] = r1[0]; bb[5] = r0[3]; bb[6] = r0[2]; bb[7] = r0[1]; }
    if (nhf) load_fraw(nhf, nhb, tl, fr);
#pragma unroll
    for (int i = 0; i < 8; ++i) {
        const float ke = f[i] + bb[i]; float ko = f[i] - bb[i]; ss += f[i] * f[i] + bb[i] * bb[i];
        if (i == 0) { ko = tl == 0 ? ke : ko; ss += tl == 0 ? 2.f * f[0] * bb[0] : 0.f; }
        E[pe + i] = (f2){ke, 0.f}; O[pe + i] = (f2){ko * tw.x, ko * tw.y}; tw = cmul(tw, WSTEP); }
    ss = wave_sum(ss);
    if ((tl & 63) == 0) red[tl >> 6] = ss;
    f2 p[16], v[16];
    tw_table((f2){1.f, 0.f}, w.w_p1, p);
    __syncthreads();
    float tot = 0.f;
#pragma unroll
    for (int q = 0; q < 8; ++q) tot += red[q];
    { LDSQ f2* a = base_p1(arr, t); read_fft<272, false>(a, v); apply_store<272>(v, p, a); }
    FFT_PIN(); tw_table((f2){1.f, 0.f}, w.w_p2, p); __syncthreads();
    { LDSQ f2* a = base_p2(arr, t); read_fft<17, false>(a, v); apply_store<17>(v, p, a); }
    __syncthreads();
    read_fft<1, false>(base_p3(arr, t), v);
    const float scale = rsqrtf(tot + EPSF) * (1.0f / 8192.0f); const float dk = dskip * (1.0f / 8192.0f);
#pragma unroll
    for (int i = 0; i < 16; ++i) K[i] = (f2){v[i].x * scale + dk, v[i].y * scale};
    __syncthreads();
}
__device__ __forceinline__ void fft_phase(const Params& P, LDSQ unsigned char* lds) {
    const bf16_t* __restrict__ pT = (const bf16_t*)(P.ws + WS_PT); bf16_t* __restrict__ yT = (bf16_t*)(P.ws + WS_YT);
    const float* __restrict__ hfilt = (const float*)(P.ws + WS_HF);
    const float* conv_w = P.in[3]; const float* conv_b = P.in[4]; const float* long_d = P.in[11];
    LDSQ f2* E = (LDSQ f2*)lds; LDSQ f2* O = E + 4352; LDSQ float* red = (LDSQ float*)(O + 4352); LDSQ f2* K1l = (LDSQ f2*)(red + 16);
    const int tid = opaque_tid(), team = tid >> 8, t = tid & 255;
    LDSQ f2* arr = team ? O : E;
    const f2 wt = twid((float)tid * (1.0f / 512.0f));
    const FftTw w = make_tw(t);
    const f2 WSTEP = (f2){0.9999997058628822f, -0.0007669903187427045f};
#pragma unroll 1
    for (int c = blockIdx.x; c < 512; c += gridDim.x) {
        const float w1a = conv_w[c], w1b = conv_w[1536 + c], w1c = conv_w[3072 + c], b1 = conv_b[c];
        const float w2a = conv_w[512 + c], w2b = conv_w[1536 + 512 + c], w2c = conv_w[3072 + 512 + c], b2 = conv_b[512 + c];
        const float wva = conv_w[1024 + c], wvb = conv_w[1536 + 1024 + c], wvc = conv_w[3072 + 1024 + c], bv = conv_b[1024 + c];
        f2 K0[16];
        const bf16_t* px1 = pT + (size_t)(512 + c) * NTOK; const bf16_t* px2 = pT + (size_t)(1024 + c) * NTOK; const bf16_t* pv = pT + (size_t)(1536 + c) * NTOK;
        bf16_t* yo = yT + (size_t)(512 + c) * NTOK;
        FRaw fr; load_fraw(hfilt + (size_t)(2 * 512 + c) * SEQ, hfilt + (size_t)(3 * 512 + c) * SEQ, opq(tid) & 511, fr);
        filter_spec(fr, hfilt + (size_t)(0 * 512 + c) * SEQ, hfilt + (size_t)(1 * 512 + c) * SEQ, long_d[512 + c], E, O, red, arr, tid, t, w, wt, K0);
        { LDSQ f2* kl = K1l + (opq(tid) & 511);
#pragma unroll
          for (int i = 0; i < 16; ++i) kl[512 * i] = K0[i]; }
        Raw8 raw;
        load_raw8(pv, pv + SEQ, opq(tid) & 511, raw);
        filter_spec(fr, nullptr, nullptr, long_d[c], E, O, red, arr, tid, t, w, wt, K0);
#pragma unroll 1
        for (int pr = 0; pr < 4; ++pr) {
            const int o1 = (2 * pr) * SEQ, o2 = (2 * pr + 1) * SEQ;
            { const int tl = opq(tid) & 511, pe = 8 * tl + (tl >> 1); f2 tw = opq2(wt);
              float ua[8], ub[8]; sconv8(raw.a, raw.la, raw.ra, tl, wva, wvb, wvc, bv, ua); sconv8(raw.b, raw.lb, raw.rb, tl, wva, wvb, wvc, bv, ub);
              load_raw8(px1 + o1, px1 + o2, tl, raw);
#pragma unroll
              for (int i = 0; i < 8; ++i) { const f2 z = (f2){ua[i], ub[i]};
                E[pe + i] = z; O[pe + i] = cmul(z, tw); tw = cmul(tw, WSTEP); } }
            conv4096<false>(arr, t, w, K0, nullptr);
            { const int tl = opq(tid) & 511, pe = 8 * tl + (tl >> 1); f2 tw = opq2(wt);
              float ua[8], ub[8]; sconv8(raw.a, raw.la, raw.ra, tl, w1a, w1b, w1c, b1, ua); sconv8(raw.b, raw.lb, raw.rb, tl, w1a, w1b, w1c, b1, ub);
              load_raw8(px2 + o1, px2 + o2, tl, raw);
#pragma unroll
              for (int i = 0; i < 8; ++i) {
                const f2 y = E[pe + i] + cmulc(O[pe + i], tw);
                const f2 z = (f2){ua[i], ub[i]} * y;
                E[pe + i] = z; O[pe + i] = cmul(z, tw); tw = cmul(tw, WSTEP); } }
            conv4096<true>(arr, t, w, K0, K1l + (opq(tid) & 511));
            { const int tl = opq(tid) & 511, pe = 8 * tl + (tl >> 1); f2 tw = opq2(wt);
              float ua[8], ub[8]; sconv8(raw.a, raw.la, raw.ra, tl, w2a, w2b, w2c, b2, ua); sconv8(raw.b, raw.lb, raw.rb, tl, w2a, w2b, w2c, b2, ub);
              { const int on = pr < 3 ? o2 + SEQ : 0; load_raw8(pv + on, pv + on + SEQ, tl, raw); }
              float za[8], zb[8];
#pragma unroll
              for (int i = 0; i < 8; ++i) {
                const f2 y = E[pe + i] + cmulc(O[pe + i], tw);
                za[i] = ua[i] * y.x; zb[i] = ub[i] * y.y; tw = cmul(tw, WSTEP); }
              u32x4 wa, wb;
              wa.x = pack2(za[0], za[1]); wa.y = pack2(za[2], za[3]); wa.z = pack2(za[4], za[5]); wa.w = pack2(za[6], za[7]);
              wb.x = pack2(zb[0], zb[1]); wb.y = pack2(zb[2], zb[3]); wb.z = pack2(zb[4], zb[5]); wb.w = pack2(zb[6], zb[7]);
              *(u32x4*)(yo + o1 + 8 * tl) = wa; *(u32x4*)(yo + o2 + 8 * tl) = wb; }
        }
    }
    __syncthreads();
    unsigned nre[16], nim[16];
    { const int J = blockIdx.x * 2 + team, b = J >> 8, g = (J >> 5) & 7, mm = J & 31, tq = opq(t) & 255;
      const bf16_t* pre = pT + (size_t)(g * 64 + mm) * NTOK + b * SEQ; const bf16_t* pim = pT + (size_t)(g * 64 + 32 + mm) * NTOK + b * SEQ;
#pragma unroll
      for (int i = 0; i < 16; ++i) { nre[i] = pre[256 * i + tq]; nim[i] = pim[256 * i + tq]; } }
#pragma unroll 1
    for (int J0 = blockIdx.x * 2; J0 < 2048; J0 += gridDim.x * 2) {
        const int J = J0 + team, b = J >> 8, g = (J >> 5) & 7, mm = J & 31;
        f2 v[16];
#pragma unroll
        for (int i = 0; i < 16; ++i) v[i] = (f2){__uint_as_float(nre[i] << 16), __uint_as_float(nim[i] << 16)};
        { const int Jn = (J0 + (int)gridDim.x * 2 < 2048 ? J0 + (int)gridDim.x * 2 : J0) + team, bn = Jn >> 8, gn = (Jn >> 5) & 7, mn = Jn & 31, tq = opq(t) & 255;
          const bf16_t* pre = pT + (size_t)(gn * 64 + mn) * NTOK + bn * SEQ; const bf16_t* pim = pT + (size_t)(gn * 64 + 32 + mn) * NTOK + bn * SEQ;
#pragma unroll
          for (int i = 0; i < 16; ++i) { nre[i] = pre[256 * i + tq]; nim[i] = pim[256 * i + tq]; } }
        f2 p[16];
        tw_table((f2){1.f, 0.f}, w.w_p1, p);
        fft16<false>(v); apply_store<272>(v, p, base_p1(arr, t));
        FFT_PIN(); tw_table((f2){1.f, 0.f}, w.w_p2, p); __syncthreads();
        { LDSQ f2* a = base_p2(arr, t); read_fft<17, false>(a, v); apply_store<17>(v, p, a); }
        __syncthreads();
        read_fft<1, false>(base_p3(arr, t), v); __syncthreads();
        { const int tq = opq(t) & 255; LDSQ f2* a = arr + ((tq >> 4) + 17 * (tq & 15));
#pragma unroll
          for (int i = 0; i < 16; ++i) a[272 * rev16(i)] = v[i]; }
        __syncthreads();
        bf16_t* q1 = yT + (size_t)(g * 64 + mm) * NTOK + b * SEQ; bf16_t* q2 = yT + (size_t)(g * 64 + (mm ? 64 - mm : 32)) * NTOK + b * SEQ;
        { const int tq = opq(t) & 255, tr = 256 - tq;
          LDSQ f2* af = arr + (tq + (tq >> 4)); LDSQ f2* ar = arr + (tr + (tr >> 4));
#pragma unroll
          for (int j = 0; j < 16; ++j) { const int k = tq + 256 * j;
            const f2 a = af[272 * j]; f2 r = ar[272 * (15 - j)];
            if (j == 0) r = tq == 0 ? a : r;
            if (mm) { q1[k] = f2bf(a.x); q2[k] = f2bf(r.x); } else { q1[k] = f2bf(0.5f * (a.x + r.x)); q2[k] = f2bf(0.5f * (a.y + r.y)); } } }
        __syncthreads();
    }
}

__device__ __forceinline__ void transpose_norm(const Params& P, LDSQ unsigned char* lds) {
    const bf16_t* __restrict__ yT = (const bf16_t*)(P.ws + WS_YT); bf16_t* __restrict__ y = (bf16_t*)(P.ws + WS_Y);
    const float* gf = P.in[12]; const float* gh = P.in[13];
    const int tid = opaque_tid(), lane = tid & 63, wid = tid >> 6;
    for (int tl = blockIdx.x; tl < NTOK / 64; tl += gridDim.x) {
        const int tok0 = tl * 64;
        __syncthreads();
        u32x4 tv[16];
#pragma unroll
        for (int i = 0; i < 16; ++i) { const int q = tid + 512 * i, ch = q >> 3, part = q & 7; tv[i] = *(const u32x4*)(yT + (size_t)ch * NTOK + tok0 + part * 8); }
#pragma unroll
        for (int i = 0; i < 16; ++i) { const int q = tid + 512 * i, ch = q >> 3, part = q & 7;
            LDSQ unsigned* d = (LDSQ unsigned*)(lds + ch * 132 + part * 16); d[0] = tv[i].x; d[1] = tv[i].y; d[2] = tv[i].z; d[3] = tv[i].w; }
        __syncthreads();
        for (int tk = wid * 8; tk < wid * 8 + 8; ++tk) {
            float va[8], vb[8]; float ssf = 0.f, ssh = 0.f;
#pragma unroll
            for (int e = 0; e < 8; ++e) { const int ch = 2 * lane + 128 * e;
                va[e] = bf2f(*(const LDSQ bf16_t*)(lds + ch * 132 + tk * 2)); vb[e] = bf2f(*(const LDSQ bf16_t*)(lds + (ch + 1) * 132 + tk * 2));
                if (e < 4) ssf += va[e] * va[e] + vb[e] * vb[e]; else ssh += va[e] * va[e] + vb[e] * vb[e]; }
            ssf = wave_sum(ssf); ssh = wave_sum(ssh);
            const float rf = rsqrtf(ssf * (1.0f / 512.0f) + EPSF), rh = rsqrtf(ssh * (1.0f / 512.0f) + EPSF);
#pragma unroll
            for (int e = 0; e < 8; ++e) { const int ch = 2 * lane + 128 * e;
                const float g0 = e < 4 ? gf[ch] : gh[ch - 512], g1 = e < 4 ? gf[ch + 1] : gh[ch + 1 - 512], r = e < 4 ? rf : rh;
                *(unsigned*)(y + (size_t)(tok0 + tk) * DM + ch) = pack2(va[e] * r * g0, vb[e] * r * g1); }
        }
    }
}

#ifndef PHASE_PROGRAM
#define PHASE_PROGRAM {0, 1, 2, 3, 4, 6, 7, 8}
#endif
__global__ __launch_bounds__(512, 2) void hybrid_fwd(Params P) {
    extern __shared__ __attribute__((aligned(16))) unsigned char shm[];
    LDSQ unsigned char* lds = (LDSQ unsigned char*)shm;
    unsigned char* ws = P.ws;
    if (P.ph_lo < 0) cg::this_grid().sync();
    volatile LDSQ unsigned* xbst = (volatile LDSQ unsigned*)(lds + LDS_XB);
    if (threadIdx.x == 0) { xbst[0] = 0u; xbst[1] = 0u; }
    __syncthreads();
    const XcdBarrier xb = xcd_barrier_post((unsigned*)(ws + WS_BAR), xbst);
    constexpr int prog[] = PHASE_PROGRAM;
    constexpr int nprog = (int)(sizeof(prog) / sizeof(int));
#pragma unroll 1
    for (int pi = P.ph_lo; pi < P.ph_hi; ++pi) {
        if (pi > P.ph_lo) xcd_barrier(xb);
        const int ph = prog[pi < nprog ? pi : 0];
        if (ph == 0) {
            LDSQ float* tile = (LDSQ float*)lds; LDSQ float* cs = tile + 64 * 65;
            { const int tq = opaque_tid(); if (tq < 64) { cs[tq] = cospif((float)tq * (1.0f / 32.0f)); cs[64 + tq] = sinpif((float)tq * (1.0f / 32.0f)); } }
            __syncthreads();
            transpose_w(P.in[2], DM, INW, (bf16_t*)(ws + WS_WIN), 512, nullptr, tile, cs);
            transpose_w(P.in[14], DM, DM, (bf16_t*)(ws + WS_WOUT), 0, nullptr, tile, cs);
            transpose_w(P.in[16], DM, DFF, (bf16_t*)(ws + WS_W1), 0, P.in[15], tile, cs);
            transpose_w(P.in[17], DFF, DM, (bf16_t*)(ws + WS_W2), 0, nullptr, tile, cs);
            __syncthreads();
            filter_mlp(P, (float*)(ws + WS_HF), (LDSQ float*)lds);
            { const int tq = opaque_tid(); if (blockIdx.x == 0) { float* igo = (float*)(ws + WS_IG); igo[tq] = 1.0f / P.in[1][tq]; igo[tq + 512] = 1.0f / P.in[1][tq + 512]; } }
            rmsnorm_rows<true>(P.in[0], P.in[1], ws + WS_H, NTOK, (float*)(ws + WS_IRS));
        } else if (ph == 1) {
            pg8::StaticOrder S; S.init(INW, NTOK, gridDim.x, blockIdx.x);
            pg8::gemm_phase(lds, pg8::Gemm{(const bf16_t*)(ws + WS_WIN), (const bf16_t*)(ws + WS_H), INW, NTOK, DM}, S, pg8::EpiBf16<0>{(bf16_t*)(ws + WS_PT), NTOK});
        } else if (ph == 2) {
            fft_phase(P, lds);
        } else if (ph == 3) {
            transpose_norm(P, lds);
        } else if (ph == 4) {
            pg8::StaticOrder S; S.init(NTOK, DM, gridDim.x, blockIdx.x);
            LDSQ float* irl = (LDSQ float*)(lds + 131072); int pmA = -1, pmB = -1;
            { pg8::Unit uu; for (int i = 0; S.next(i, uu); ++i) { if (pmA < 0) pmA = uu.pm; else if (uu.pm != pmA && pmB < 0) pmB = uu.pm; } }
            { const int tq = opaque_tid(), slot = tq >> 8, pmq = slot ? pmB : pmA;
              if (pmq >= 0) irl[tq] = ((const float*)(ws + WS_IRS))[pmq * 256 + (tq & 255)]; }
            __syncthreads();
            pg8::gemm_phase(lds, pg8::Gemm{(const bf16_t*)(ws + WS_Y), (const bf16_t*)(ws + WS_WOUT), NTOK, DM, DM}, S,
                            pg8::EpiResBf16SS<2>{(const bf16_t*)(ws + WS_H), (bf16_t*)(ws + WS_X1), (float*)(ws + WS_SS1), DM, irl, pmA, pmB, (const float*)(ws + WS_IRS), (const float*)(ws + WS_IG)});
        } else if (ph == 6) {
            pg8::StaticOrder S; S.init(NTOK, DFF, gridDim.x, blockIdx.x);
            LDSQ float* rsl = (LDSQ float*)(lds + 131072); int pmA = -1, pmB = -1;
            { pg8::Unit uu; for (int i = 0; S.next(i, uu); ++i) { if (pmA < 0) pmA = uu.pm; else if (uu.pm != pmA && pmB < 0) pmB = uu.pm; } }
            { const int tq = opaque_tid(), slot = tq >> 8, pmq = slot ? pmB : pmA;
              if (pmq >= 0) { const f32x4* sp = (const f32x4*)((const float*)(ws + WS_SS1) + (size_t)(pmq * 256 + (tq & 255)) * 16); const f32x4 s4 = (sp[0] + sp[1]) + (sp[2] + sp[3]);
                rsl[tq] = rsqrtf((s4[0] + s4[1] + s4[2] + s4[3]) * (1.0f / 1024.0f) + 1e-5f); } }
            __syncthreads();
            pg8::gemm_phase(lds, pg8::Gemm{(const bf16_t*)(ws + WS_X1), (const bf16_t*)(ws + WS_W1), NTOK, DFF, DM}, S, pg8::EpiScaleRelu2{(bf16_t*)(ws + WS_A), (const float*)(ws + WS_SS1), DFF, rsl, pmA, pmB});
        } else if (ph == 7) {
            pg8::StaticOrder S; S.init(NTOK, DM, gridDim.x, blockIdx.x);
            pg8::gemm_phase(lds, pg8::Gemm{(const bf16_t*)(ws + WS_A), (const bf16_t*)(ws + WS_W2), NTOK, DM, DFF}, S, pg8::EpiResBf16SS<1>{(const bf16_t*)(ws + WS_X1), (bf16_t*)(ws + WS_X2), (float*)(ws + WS_SS2), DM, nullptr, -1, -1, nullptr, nullptr});
        } else if (ph == 8) {
            final_norm((const bf16_t*)(ws + WS_X2), (const float*)(ws + WS_SS2), P.in[18], P.out);
        }
    }
}

extern "C" void kernel_launch(void* const* d_in, const int* in_sizes, int n_in, void* d_out, int out_size, void* d_ws, size_t ws_size, hipStream_t stream) {
    static int grid = 0;
    if (grid == 0) {
        if (n_in != 19 || in_sizes[0] != NTOK * DM || out_size != NTOK * DM || ws_size < WS_END) { fprintf(stderr, "kernel_launch: unexpected shapes (n_in %d, in0 %d, out %d, ws %zu)\n", n_in, n_in > 0 ? in_sizes[0] : -1, out_size, ws_size); grid = -1; return; }
        int dev = 0, cus = 0, per_cu = 0;
        hipGetDevice(&dev); hipDeviceGetAttribute(&cus, hipDeviceAttributeMultiprocessorCount, dev);
        if (hipFuncSetAttribute((const void*)hybrid_fwd, hipFuncAttributeMaxDynamicSharedMemorySize, LDS_BYTES) != hipSuccess) { fprintf(stderr, "kernel_launch: hipFuncSetAttribute failed\n"); grid = -1; return; }
        if (hipOccupancyMaxActiveBlocksPerMultiprocessor(&per_cu, (const void*)hybrid_fwd, 512, LDS_BYTES) != hipSuccess || per_cu < 1) { fprintf(stderr, "kernel_launch: occupancy query gave %d\n", per_cu); per_cu = 1; }
        (void)hipGetLastError();
        grid = cus;
    }
    if (grid < 0) return;
    Params p{};
    for (int i = 0; i < 19; ++i) p.in[i] = (const float*)d_in[i];
    p.out = (float*)d_out; p.ws = (unsigned char*)d_ws;
    constexpr int progh[] = PHASE_PROGRAM;
    constexpr int NPH = (int)(sizeof(progh) / sizeof(int));
    if (hipMemsetAsync((unsigned char*)d_ws + WS_BAR, 0, XCD_BAR_WORDS * sizeof(unsigned), stream) != hipSuccess) { fprintf(stderr, "kernel_launch: memset of the barrier words failed\n"); return; }
    for (int li = 0; li < N_LAUNCHES; ++li) {
        p.ph_lo = (N_LAUNCHES == 1) ? 0 : li; p.ph_hi = (N_LAUNCHES == 1) ? NPH : li + 1;
        void* args[] = {&p};
        hipError_t e = hipLaunchCooperativeKernel((const void*)hybrid_fwd, dim3(grid), dim3(512), args, LDS_BYTES, stream);
        if (e != hipSuccess) { fprintf(stderr, "kernel_launch: cooperative launch %d failed: %s (grid %d)\n", li, hipGetErrorString(e), grid); break; }
    }
}
```
